# Optimizing an MI355X kernel written in HIP

```python
import jax, jax.numpy as jnp
from jax import lax
import numpy as np

D_MODEL = 4096
BATCH = 1
SEQ = 16384
DEPTH = 4

HEAD_DIM = 128
MIX_WIDTH = D_MODEL
D_GMLP = MIX_WIDTH // 2
D_NA = MIX_WIDTH - D_GMLP
HEADS_GMLP = D_GMLP // HEAD_DIM
HEADS_NA = D_NA // HEAD_DIM
D_IN = 2 * D_GMLP + 3 * D_NA
CHUNK = 128
GRID_W = 64
WIN_ROWS_MAX = 8
WIN_COLS = 16
D_FF = 4 * D_MODEL
N_MOD = 6
EPS = 1e-6

kernel_name = "hybrid_gmlp_natten_encoder"


def rms_norm(x, w):
    xf = x.astype(jnp.float32)
    y = xf * lax.rsqrt(jnp.mean(xf * xf, axis=-1, keepdims=True) + EPS)
    return y.astype(x.dtype) * w


def modulate(h, shift, scale):
    return h * (1 + scale[:, None, :]) + shift[:, None, :]


def chunked_spatial_gating(u, v, w_s, b_s, v_norm_w):
    B, S, _ = u.shape
    n = S // CHUNK
    vh = rms_norm(v.reshape(B, n, CHUNK, HEADS_GMLP, HEAD_DIM), v_norm_w)
    mixed = jnp.einsum('hpc,bnchd->bnphd', w_s, vh) + b_s.T[:, :, None]
    return u * mixed.reshape(B, S, D_GMLP)


def neighbourhood_attention(q, k, v, rpb):
    B, S, H, DH = q.shape
    rows = S // GRID_W
    wr = min(WIN_ROWS_MAX, rows)
    qg = q.reshape(B, rows, GRID_W, H, DH)
    kg = k.reshape(B, rows, GRID_W, H, DH)
    vg = v.reshape(B, rows, GRID_W, H, DH)
    cols = jnp.arange(GRID_W)
    col_start = jnp.clip(cols - WIN_COLS // 2, 0, GRID_W - WIN_COLS)
    col_idx = col_start[:, None] + jnp.arange(WIN_COLS)[None, :]
    dc = col_idx - cols[:, None] + (WIN_COLS - 1)
    bias_c = rpb[:, :, dc]
    scale = DH ** -0.5

    def row_block(r):
        rs = jnp.clip(r - wr // 2, 0, rows - wr)
        kb = lax.dynamic_slice_in_dim(kg, rs, wr, axis=1)
        vb = lax.dynamic_slice_in_dim(vg, rs, wr, axis=1)
        kw = kb[:, :, col_idx]
        vw = vb[:, :, col_idx]
        qr = lax.dynamic_index_in_dim(qg, r, axis=1, keepdims=False)
        dr = rs + jnp.arange(wr) - r + (WIN_ROWS_MAX - 1)
        bias = jnp.take(bias_c, dr, axis=1).transpose(0, 2, 1, 3)
        s = jnp.einsum('bqhd,brqkhd->bhqrk', qr, kw).astype(jnp.float32) * scale
        s = s + bias[None].astype(jnp.float32)
        p = jax.nn.softmax(s.reshape(B, H, GRID_W, wr * WIN_COLS), axis=-1)
        p = p.reshape(s.shape).astype(v.dtype)
        return jnp.einsum('bhqrk,brqkhd->bqhd', p, vw)

    out = lax.map(row_block, jnp.arange(rows))
    return out.transpose(1, 0, 2, 3, 4).reshape(B, S, H * DH)


def setup_inputs(seed: int = 0) -> dict:
    key = jax.random.key(seed)
    ks = jax.random.split(key, 20)
    f = jnp.float32
    nrm = lambda k, shape, s: (jax.random.normal(k, shape, f) * s).astype(f)
    return {
        "x": nrm(ks[0], (BATCH, SEQ, D_MODEL), 1.0),
        "c": nrm(ks[1], (BATCH, D_MODEL), 1.0),
        "w_ada": nrm(ks[2], (D_MODEL, N_MOD * D_MODEL), 0.5 * D_MODEL ** -0.5),
        "b_ada": nrm(ks[3], (N_MOD * D_MODEL,), 0.02),
        "ada_table": nrm(ks[4], (DEPTH, N_MOD, D_MODEL), 0.1),
        "norm1_w": 1.0 + nrm(ks[5], (DEPTH, D_MODEL), 0.05),
        "w_in": nrm(ks[6], (DEPTH, D_MODEL, D_IN), D_MODEL ** -0.5),
        "v_norm_w": 1.0 + nrm(ks[7], (DEPTH, HEADS_GMLP, HEAD_DIM), 0.05),
        "w_s": nrm(ks[8], (DEPTH, HEADS_GMLP, CHUNK, CHUNK), CHUNK ** -0.5),
        "b_s": 1.0 + nrm(ks[9], (DEPTH, HEADS_GMLP, CHUNK), 0.1),
        "q_norm_w": 1.0 + nrm(ks[10], (DEPTH, HEAD_DIM), 0.05),
        "k_norm_w": 1.0 + nrm(ks[11], (DEPTH, HEAD_DIM), 0.05),
        "rpb": nrm(ks[12], (DEPTH, HEADS_NA, 2 * WIN_ROWS_MAX - 1, 2 * WIN_COLS - 1), 0.5),
        "w_out": nrm(ks[13], (DEPTH, MIX_WIDTH, D_MODEL), MIX_WIDTH ** -0.5),
        "norm2_w": 1.0 + nrm(ks[14], (DEPTH, D_MODEL), 0.05),
        "w1": nrm(ks[15], (DEPTH, D_MODEL, D_FF), D_MODEL ** -0.5),
        "w2": nrm(ks[16], (DEPTH, D_FF, D_MODEL), D_FF ** -0.5),
    }


def reference(x, c, w_ada, b_ada, ada_table, norm1_w, w_in, v_norm_w, w_s, b_s,
              q_norm_w, k_norm_w, rpb, w_out, norm2_w, w1, w2):
    B, S, D = x.shape
    cond = (jax.nn.silu(c) @ w_ada + b_ada).reshape(B, N_MOD, D)
    for l in range(DEPTH):
        mod = cond + ada_table[l][None]
        shift1, scale1, gate1 = mod[:, 0], mod[:, 1], mod[:, 2]
        shift2, scale2, gate2 = mod[:, 3], mod[:, 4], mod[:, 5]

        h = modulate(rms_norm(x, norm1_w[l]), shift1, scale1)
        z = h @ w_in[l]
        o1 = D_GMLP
        o2 = 2 * D_GMLP
        o3 = o2 + D_NA
        o4 = o3 + D_NA
        u_a = jax.nn.gelu(z[..., :o1])
        v_a = jax.nn.gelu(z[..., o1:o2])
        q_b = rms_norm(z[..., o2:o3].reshape(B, S, HEADS_NA, HEAD_DIM), q_norm_w[l])
        k_b = rms_norm(z[..., o3:o4].reshape(B, S, HEADS_NA, HEAD_DIM), k_norm_w[l])
        v_b = z[..., o4:].reshape(B, S, HEADS_NA, HEAD_DIM)

        out_a = chunked_spatial_gating(u_a, v_a, w_s[l], b_s[l], v_norm_w[l])
        out_b = neighbourhood_attention(q_b, k_b, v_b, rpb[l])
        mix = jnp.concatenate([out_a, out_b], axis=-1) @ w_out[l]
        x = x + gate1[:, None, :] * mix

        h2 = modulate(rms_norm(x, norm2_w[l]), shift2, scale2)
        ff = jnp.square(jax.nn.relu(h2 @ w1[l])) @ w2[l]
        x = x + gate2[:, None, :] * ff
    return x
```

```cpp
#include <hip/hip_runtime.h>
#include <cstdio>
#include <cstdint>

#ifndef MK_PER_PHASE
#define MK_PER_PHASE 0
#endif

namespace pg8 {
#define PG8_LAS __attribute__((address_space(3)))
typedef unsigned short bf16_t;
typedef short bf16x8 __attribute__((ext_vector_type(8)));
typedef float f32x4 __attribute__((ext_vector_type(4)));
typedef float f32x2 __attribute__((ext_vector_type(2)));
typedef unsigned u32x4 __attribute__((ext_vector_type(4)));
constexpr int BM = 256, BK = 64, HALF = 128, HTB = HALF * BK * 2  , STAGE_BYTES = 8 * HTB, NXCD = 8, WGM = 8;

__host__ __device__ __forceinline__ int lds_byte(int r, int c) { const int st = (r >> 4) * 2 + (c >> 5), rr = r & 15, cc = c & 31, ob = rr * 64 + cc * 2; return st * 1024 + (ob ^ (((ob >> 9) & 1) << 5)); }
__host__ __device__ __forceinline__ void stage_rc(int b, int& R, int& C) { const int st = b / 1024, sb = b % 1024, swz = sb ^ (((sb >> 9) & 1) << 5); R = (st >> 1) * 16 + swz / 64; C = (st & 1) * 32 + (swz % 64) / 2; }
__host__ __device__ __forceinline__ int perm32(int rho) { const int n = rho >> 4, i = rho & 15; return 8 * (i >> 2) + 4 * n + (i & 3); }

struct Unit { int pm, pn; };
struct Gemm { const bf16_t* A; const bf16_t* Bt; int M, N, K; };
__host__ __device__ __forceinline__ size_t ioff(int row, int col, int rows) { return ((size_t)(col >> 6) * (rows >> 7) + (row >> 7)) * 8192 + (size_t)(lds_byte(row & 127, col & 63) >> 1); }
constexpr size_t IMG_KT = (size_t)(16384 / 128) * 8192;
__host__ __device__ __forceinline__ int invperm32(int x) { return 16 * ((x >> 2) & 1) + 4 * (x >> 3) + (x & 3); }
__host__ __device__ __forceinline__ size_t ioffB(int n, int k, int N) { return ioff((n & ~31) | invperm32(n & 31), k, N); }

struct StaticOrder {
    int nM, nN, nwg, G, c;
    __host__ __device__ void init(int M, int N, int G_, int c_) { nM = M / BM; nN = N / BM; nwg = nM * nN; G = G_; c = c_; }
    __host__ __device__ bool next(int i, Unit& u) const {
        const long L = (long)i * G + c; if (L >= nwg) return false;
        int wgid = (int)L; { const int q = nwg / NXCD, r = nwg % NXCD, xcd = wgid % NXCD, off = wgid / NXCD; wgid = (xcd < r ? xcd * (q + 1) : r * (q + 1) + (xcd - r) * q) + off; }
        const int nig = WGM * nN, gid = wgid / nig, fm = gid * WGM, gsz = (nM - fm) < WGM ? (nM - fm) : WGM;
        u.pm = fm + ((wgid % nig) % gsz); u.pn = (wgid % nig) / gsz; return true;
    }
    __device__ __forceinline__ void a_ready(const Unit&) const {}
    __device__ __forceinline__ void done(const Unit&) const {}
};

__device__ __forceinline__ unsigned cvt_pk_bf16(float lo, float hi) { unsigned r; asm volatile("v_cvt_pk_bf16_f32 %0, %1, %2" : "=v"(r) : "v"(lo), "v"(hi)); return r; }

__device__ __forceinline__ float gelu_tanh(float x) {
    const float y = x * (1.0f + 0.044715f * x * x) * (-2.302208198f);
    return x * __builtin_amdgcn_rcpf(1.0f + __builtin_amdgcn_exp2f(y));
}


constexpr int DIN_C = 10240, ZM_C = 16384;
constexpr float QSCALE = 0.08838834764831845f * 1.4426950408889634f;
constexpr float RMS_EPS = 1e-6f;

struct RowScale {
    const float* ssq; const float* bias; PG8_LAS float* rtab; PG8_LAS float* btab;
    struct Regs { f32x4 a, b, c; };
    __device__ __forceinline__ void issue(const Unit& nx, int t, Regs& r) const {
        const f32x4* sp = (const f32x4*)(ssq + (size_t)(nx.pm * BM + (t >> 1)) * 16 + (t & 1) * 8);
        r.a = sp[0]; r.b = sp[1];
        r.c = *(const f32x4*)(bias + nx.pn * BM + 4 * (t & 63));
    }
    __device__ __forceinline__ void commit(int par, int t, const Regs& r) const {
        float s = ((r.a[0] + r.a[1]) + (r.a[2] + r.a[3])) + ((r.b[0] + r.b[1]) + (r.b[2] + r.b[3]));
        s += __shfl_xor(s, 1);
        if ((t & 1) == 0) rtab[par * BM + (t >> 1)] = __builtin_amdgcn_rsqf(s * (1.0f / 4096.0f) + RMS_EPS);
        if (t < 64) *(PG8_LAS f32x4*)&btab[par * BM + 4 * t] = r.c;
    }
    __device__ __forceinline__ void apply(f32x4 (&acc)[2][2][4][2], int par, int wr, int wc, int fr, int fq) const {
        f32x4 bv[2][2];
#pragma unroll
        for (int bj = 0; bj < 2; ++bj)
#pragma unroll
            for (int n = 0; n < 2; ++n) bv[bj][n] = *(const PG8_LAS f32x4*)&btab[par * BM + wc * 32 + 8 * fq + bj * HALF + 4 * n];
#pragma unroll
        for (int ai = 0; ai < 2; ++ai)
#pragma unroll
            for (int m = 0; m < 4; ++m) { const float rs = rtab[par * BM + ai * HALF + wr * 64 + m * 16 + fr];
#pragma unroll
                for (int bj = 0; bj < 2; ++bj)
#pragma unroll
                    for (int n = 0; n < 2; ++n) acc[ai][bj][m][n] = acc[ai][bj][m][n] * rs + bv[bj][n]; }
    }
};

struct EpiIn {
    static constexpr bool PERM = true, AFTER_DRAIN = false;
    bf16_t* Z; const float* vnw; const float* qnw; const float* knw; RowScale rsb; PG8_LAS float* tab;
    __device__ __forceinline__ void first(const Unit& u, int t) const { RowScale::Regs r; rsb.issue(u, t, r); rsb.commit(0, t, r); }
    __device__ __forceinline__ void operator()(f32x4 (&acc)[2][2][4][2], const Unit& u, const Unit& nx, bool has_next, int par, int wr, int wc, int fr, int fq) const {
        const int type = u.pn >> 3;
        const int row0 = u.pm * BM + wr * 64 + fr, col0 = u.pn * BM + wc * 32 + 8 * fq;
        const int t = (((wr << 2) | wc) << 6) | (fq << 4) | fr;
        rsb.apply(acc, par, wr, wc, fr, fq);
        asm volatile("" ::: "memory");
        RowScale::Regs pr; rsb.issue(has_next ? nx : u, t, pr);
        f32x4 wv[2][2];
        { const float* wp = (type == 1) ? (vnw + (u.pn - 8) * 256) : (type == 2 ? qnw : knw);
#pragma unroll
          for (int bj = 0; bj < 2; ++bj) { const float* w = wp + (type == 1 ? bj * HALF : 0) + wc * 32 + 8 * fq;
              wv[bj][0] = *(const f32x4*)w; wv[bj][1] = *(const f32x4*)(w + 4); } }
        if (type <= 1) {
#pragma unroll
            for (int ai = 0; ai < 2; ++ai)
#pragma unroll
                for (int bj = 0; bj < 2; ++bj)
#pragma unroll
                    for (int m = 0; m < 4; ++m)
#pragma unroll
                        for (int n = 0; n < 2; ++n)
#pragma unroll
                            for (int j = 0; j < 4; ++j) acc[ai][bj][m][n][j] = gelu_tanh(acc[ai][bj][m][n][j]);
        }
        if (type >= 1 && type <= 3) {
#pragma unroll
            for (int ai = 0; ai < 2; ++ai)
#pragma unroll
                for (int m = 0; m < 4; ++m)
#pragma unroll
                    for (int bj = 0; bj < 2; ++bj) {
                        const f32x4 a = acc[ai][bj][m][0], b = acc[ai][bj][m][1];
                        float s = (a[0] * a[0] + a[1] * a[1]) + (a[2] * a[2] + a[3] * a[3]) + (b[0] * b[0] + b[1] * b[1]) + (b[2] * b[2] + b[3] * b[3]);
                        s += __shfl_xor(s, 16); s += __shfl_xor(s, 32);
                        if (fq == 0) tab[((ai * HALF + wr * 64 + m * 16 + fr) * 2 + bj) * 4 + wc] = s;
                    }
            asm volatile("s_waitcnt lgkmcnt(0)" ::: "memory"); __builtin_amdgcn_s_barrier(); asm volatile("" ::: "memory");
            const float wmul = (type == 2) ? QSCALE : 1.0f;
#pragma unroll
            for (int ai = 0; ai < 2; ++ai)
#pragma unroll
                for (int m = 0; m < 4; ++m) {
#pragma unroll
                    for (int bj = 0; bj < 2; ++bj) {
                        const f32x4 p = *(const PG8_LAS f32x4*)&tab[((ai * HALF + wr * 64 + m * 16 + fr) * 2 + bj) * 4];
                        const float rstd = __builtin_amdgcn_rsqf(((p[0] + p[1]) + (p[2] + p[3])) * (1.0f / 128.0f) + RMS_EPS);
                        acc[ai][bj][m][0] = acc[ai][bj][m][0] * (wv[bj][0] * (rstd * wmul)); acc[ai][bj][m][1] = acc[ai][bj][m][1] * (wv[bj][1] * (rstd * wmul));
                    }
                    asm volatile("" ::: "memory");
                }
        }
        rsb.commit(par ^ 1, t, pr);
        asm volatile("" ::: "memory");
#pragma unroll
        for (int ai = 0; ai < 2; ++ai)
#pragma unroll
            for (int m = 0; m < 4; ++m) { bf16_t* rowp = Z + ((size_t)(u.pn * 2) * ZM_C + (size_t)(row0 + ai * HALF + m * 16)) * HALF + wc * 32 + 8 * fq;
#pragma unroll
                for (int bj = 0; bj < 2; ++bj) { const f32x4 v0 = acc[ai][bj][m][0], v1 = acc[ai][bj][m][1];
                    u32x4 w; w.x = cvt_pk_bf16(v0[0], v0[1]); w.y = cvt_pk_bf16(v0[2], v0[3]); w.z = cvt_pk_bf16(v1[0], v1[1]); w.w = cvt_pk_bf16(v1[2], v1[3]);
                    *(u32x4*)(rowp + (size_t)bj * ZM_C * HALF) = w; }
                asm volatile("" ::: "memory"); }
    }
};

struct EpiResid {
    static constexpr bool PERM = true, AFTER_DRAIN = false;
    const float* xin32; bf16_t* xb; float* out32; const float* gate; float* ssq; PG8_LAS float* tab; int ldc;
    __device__ __forceinline__ void first(const Unit&, int) const {}
    template <bool OUT32>
    __device__ __forceinline__ void body(f32x4 (&acc)[2][2][4][2], size_t off0, int irow0, int icol0, int wr, int wc, int fr, int fq) const {
        f32x4 gt[2][2];
#pragma unroll
        for (int bj = 0; bj < 2; ++bj)
#pragma unroll
            for (int n = 0; n < 2; ++n) gt[bj][n] = *(const f32x4*)(gate + icol0 + bj * HALF + 4 * n);
        const size_t ib0 = ioff(irow0, icol0, ZM_C);
        u32x4 xh[8][2];
#pragma unroll
        for (int gi = 0; gi < 8; ++gi)
#pragma unroll
            for (int bj = 0; bj < 2; ++bj) xh[gi][bj] = *(const u32x4*)(xb + ib0 + (size_t)bj * 2 * IMG_KT + (gi >> 2) * 8192 + (gi & 3) * 1024);
#pragma unroll
        for (int gi = 0; gi < 8; ++gi) { const int ai = gi >> 2, m = gi & 3; const size_t off = off0 + (size_t)(ai * HALF + m * 16) * ldc;
            float sq = 0.f;
#pragma unroll
            for (int bj = 0; bj < 2; ++bj) { f32x4 xn[2]; const u32x4 h = xh[gi][bj];
                xn[0] = (f32x4){__builtin_bit_cast(float, h.x << 16), __builtin_bit_cast(float, h.x & 0xffff0000u), __builtin_bit_cast(float, h.y << 16), __builtin_bit_cast(float, h.y & 0xffff0000u)};
                xn[1] = (f32x4){__builtin_bit_cast(float, h.z << 16), __builtin_bit_cast(float, h.z & 0xffff0000u), __builtin_bit_cast(float, h.w << 16), __builtin_bit_cast(float, h.w & 0xffff0000u)};
#pragma unroll
                for (int n = 0; n < 2; ++n) { xn[n] = xn[n] + gt[bj][n] * acc[ai][bj][m][n];
                    if (OUT32) *(f32x4*)(out32 + off + bj * HALF + 4 * n) = xn[n];
                    else sq += (xn[n][0] * xn[n][0] + xn[n][1] * xn[n][1]) + (xn[n][2] * xn[n][2] + xn[n][3] * xn[n][3]); }
                if (!OUT32) { u32x4 w; w.x = cvt_pk_bf16(xn[0][0], xn[0][1]); w.y = cvt_pk_bf16(xn[0][2], xn[0][3]); w.z = cvt_pk_bf16(xn[1][0], xn[1][1]); w.w = cvt_pk_bf16(xn[1][2], xn[1][3]);
                    *(u32x4*)(xb + ib0 + (size_t)bj * 2 * IMG_KT + ai * 8192 + m * 1024) = w; } }
            if (!OUT32) { sq += __shfl_xor(sq, 16); sq += __shfl_xor(sq, 32); if (fq == 0) tab[(ai * HALF + wr * 64 + m * 16 + fr) * 4 + wc] = sq; }
        }
    }
    __device__ __forceinline__ void operator()(f32x4 (&acc)[2][2][4][2], const Unit& u, const Unit&, bool, int, int wr, int wc, int fr, int fq) const {
        const int row0 = u.pm * BM + wr * 64 + fr, col0 = u.pn * BM + wc * 32 + 8 * fq;
        const size_t off0 = (size_t)row0 * ldc + col0;
        if (__builtin_amdgcn_readfirstlane((int)(out32 != nullptr))) body<true>(acc, off0, row0, col0, wr, wc, fr, fq);
        else body<false>(acc, off0, row0, col0, wr, wc, fr, fq);
        if (out32 == nullptr) {
            asm volatile("s_waitcnt lgkmcnt(0)" ::: "memory"); __builtin_amdgcn_s_barrier(); asm volatile("" ::: "memory");
            const int t = (((wr << 2) | wc) << 6) | (fq << 4) | fr;
            if (t < BM) { const f32x4 p = *(const PG8_LAS f32x4*)&tab[t * 4]; ssq[(size_t)(u.pm * BM + t) * 16 + u.pn] = (p[0] + p[1]) + (p[2] + p[3]); }
        }
    }
};

struct EpiRelu2 {
    static constexpr bool PERM = true, AFTER_DRAIN = false;
    bf16_t* O; int ldc; RowScale rsb;
    __device__ __forceinline__ void first(const Unit& u, int t) const { RowScale::Regs r; rsb.issue(u, t, r); rsb.commit(0, t, r); }
    __device__ __forceinline__ void operator()(f32x4 (&acc)[2][2][4][2], const Unit& u, const Unit& nx, bool has_next, int par, int wr, int wc, int fr, int fq) const {
        const int row0 = u.pm * BM + wr * 64 + fr, col0 = u.pn * BM + wc * 32 + 8 * fq;
        const int t = (((wr << 2) | wc) << 6) | (fq << 4) | fr;
        rsb.apply(acc, par, wr, wc, fr, fq);
        asm volatile("" ::: "memory");
        RowScale::Regs pr; rsb.issue(has_next ? nx : u, t, pr);
#pragma unroll
        for (int ai = 0; ai < 2; ++ai)
#pragma unroll
            for (int bj = 0; bj < 2; ++bj)
#pragma unroll
                for (int m = 0; m < 4; ++m)
#pragma unroll
                    for (int n = 0; n < 2; ++n)
#pragma unroll
                        for (int j = 0; j < 4; ++j) { const float a = fmaxf(acc[ai][bj][m][n][j], 0.f); acc[ai][bj][m][n][j] = a * a; }
        rsb.commit(par ^ 1, t, pr);
        asm volatile("" ::: "memory");
        const size_t ib0 = ioff(row0, col0, ZM_C);
#pragma unroll
        for (int ai = 0; ai < 2; ++ai)
#pragma unroll
            for (int m = 0; m < 4; ++m) {
#pragma unroll
                for (int bj = 0; bj < 2; ++bj) { const f32x4 v0 = acc[ai][bj][m][0], v1 = acc[ai][bj][m][1];
                    u32x4 w; w.x = cvt_pk_bf16(v0[0], v0[1]); w.y = cvt_pk_bf16(v0[2], v0[3]); w.z = cvt_pk_bf16(v1[0], v1[1]); w.w = cvt_pk_bf16(v1[2], v1[3]);
                    *(u32x4*)(O + ib0 + (size_t)bj * 2 * IMG_KT + ai * 8192 + m * 1024) = w; } }
    }
};

template <class Epi, class Sched, bool ALIGN_EPI = false, bool SP2 = false>
__device__ __forceinline__ void gemm_phase(PG8_LAS unsigned char* lds, const Gemm g, const Sched& S, const Epi& E) {
    int tid = threadIdx.x; asm volatile("" : "+v"(tid));
    __builtin_amdgcn_s_waitcnt(0);
    const int wid = __builtin_amdgcn_readfirstlane(tid >> 6), lane = tid & 63, wr = wid >> 2, wc = wid & 3, fr = lane & 15, fq = lane >> 4;
    const int K = g.K, nt = K / BK;
    static_assert(Epi::PERM, "the weight copies are written in the PERM row order");
    unsigned voffA[2], voffB[2];
#pragma unroll
    for (int i = 0; i < 2; ++i) { voffA[i] = (unsigned)(tid * 16 + i * 8192); voffB[i] = voffA[i]; }
    const size_t kstepA = (size_t)g.M * BK * 2, kstepB = (size_t)g.N * BK * 2;
    const size_t hstep = (size_t)HALF * BK * 2;
    const size_t tstep = 2 * hstep;
    const unsigned ldsw = (unsigned)wid * 1024u;
    const unsigned ldsbase = (unsigned)(size_t)lds;
    const int aoff = lds_byte(wr * 64 + fr, fq * 8), boff = lds_byte(wc * 32 + fr, fq * 8);
#define PG8_SA(b, h) (((b) * 2 + (h)) * HTB)
#define PG8_SB(b, h) ((4 + (b) * 2 + (h)) * HTB)
#define PG8_STAGE(bufoff, gbase, voff) do { _Pragma("unroll") for (int _i = 0; _i < 2; ++_i) { \
        const unsigned _m0 = (unsigned)__builtin_amdgcn_readfirstlane((int)(ldsbase + (unsigned)(bufoff) + ldsw + _i * 8192)); \
        asm volatile("s_mov_b32 m0, %2\n\ts_nop 0\n\tglobal_load_lds_dwordx4 %0, %1" :: "v"((voff)[_i]), "s"(gbase), "s"(_m0) : "memory", "m0"); } } while (0)
#define PG8_LDA(dst, b, h) do { _Pragma("unroll") for (int m = 0; m < 4; ++m) _Pragma("unroll") for (int k = 0; k < 2; ++k) dst[m][k] = *(const PG8_LAS bf16x8*)(lds + PG8_SA(b, h) + aoff + m * 2048 + k * 1024); } while (0)
#define PG8_LDB(dst, b, h) do { _Pragma("unroll") for (int n = 0; n < 2; ++n) _Pragma("unroll") for (int k = 0; k < 2; ++k) dst[n][k] = *(const PG8_LAS bf16x8*)(lds + PG8_SB(b, h) + boff + n * 2048 + k * 1024); } while (0)
#define PG8_MMA(ai, bj, At, Bt) do { __builtin_amdgcn_s_setprio(1); _Pragma("unroll") for (int m = 0; m < 4; ++m) _Pragma("unroll") for (int n = 0; n < 2; ++n) _Pragma("unroll") for (int k = 0; k < 2; ++k) \
        acc[ai][bj][m][n] = __builtin_amdgcn_mfma_f32_16x16x32_bf16(Bt[n][k], At[m][k], acc[ai][bj][m][n], 0, 0, 0); __builtin_amdgcn_s_setprio(0); } while (0)
#define PG8_WAIT_V(n) asm volatile("s_waitcnt vmcnt(" #n ")" ::: "memory")
#define PG8_WAIT_L(n) asm volatile("s_waitcnt lgkmcnt(" #n ")" ::: "memory")
#define PG8_BAR __builtin_amdgcn_s_barrier()
#define PG8_SCHED __builtin_amdgcn_sched_barrier(0)
    Unit cur, nxt; int ui = 0;
    if (!S.next(0, cur)) return;
    f32x4 acc[2][2][4][2];
#pragma unroll
    for (int a = 0; a < 2; ++a)
#pragma unroll
        for (int b = 0; b < 2; ++b)
#pragma unroll
            for (int m = 0; m < 4; ++m)
#pragma unroll
                for (int n = 0; n < 2; ++n) acc[a][b][m][n] = (f32x4){0.f, 0.f, 0.f, 0.f};
    bf16x8 At[4][2], B0[2][2], B1[2][2];
    const char* cA = (const char*)g.A + (size_t)cur.pm * tstep; const char* cB = (const char*)g.Bt + (size_t)cur.pn * tstep;
    S.a_ready(cur);
    E.first(cur, tid);
    if constexpr (SP2) {
        PG8_STAGE(PG8_SB(0, 0), cB, voffB); PG8_STAGE(PG8_SB(0, 1), cB + hstep, voffB); PG8_STAGE(PG8_SA(0, 0), cA, voffA); PG8_STAGE(PG8_SA(0, 1), cA + hstep, voffA);
        if (wr == 1) PG8_BAR;
        PG8_WAIT_V(2); PG8_BAR;
        PG8_STAGE(PG8_SB(1, 0), cB + kstepB, voffB); PG8_STAGE(PG8_SA(1, 0), cA + kstepA, voffA); PG8_STAGE(PG8_SB(1, 1), cB + hstep + kstepB, voffB);
        PG8_WAIT_V(6); PG8_BAR;
    } else {
        PG8_STAGE(PG8_SB(0, 0), cB, voffB); PG8_STAGE(PG8_SA(0, 0), cA, voffA); PG8_STAGE(PG8_SB(0, 1), cB + hstep, voffB); PG8_STAGE(PG8_SA(0, 1), cA + hstep, voffA);
        if (wr == 1) PG8_BAR;
        PG8_WAIT_V(4); PG8_BAR;
        PG8_STAGE(PG8_SB(1, 0), cB + kstepB, voffB); PG8_STAGE(PG8_SA(1, 0), cA + kstepA, voffA); PG8_STAGE(PG8_SB(1, 1), cB + hstep + kstepB, voffB);
        PG8_WAIT_V(6); PG8_BAR;
    }
    for (;;) {
        const bool has_next = S.next(ui + 1, nxt);
        const char* nA = has_next ? (const char*)g.A + (size_t)nxt.pm * tstep : cA; const char* nB = has_next ? (const char*)g.Bt + (size_t)nxt.pn * tstep : cB;
        for (int t = 0; t < nt; t += 2) {
            const bool last = (t == nt - 2);
            const char* a1 = cA + (size_t)(t + 1) * kstepA;
            const char* a2 = last ? nA : cA + (size_t)(t + 2) * kstepA; const char* b2 = last ? nB : cB + (size_t)(t + 2) * kstepB;
            const char* a3 = a2 + kstepA; const char* b3 = b2 + kstepB;
            if (last && has_next) S.a_ready(nxt);
            if constexpr (SP2) {
            PG8_STAGE(PG8_SA(1, 1), a1 + hstep, voffA); PG8_LDB(B0, 0, 0); PG8_LDB(B1, 0, 1); PG8_SCHED; PG8_LDA(At, 0, 0);
            PG8_WAIT_V(8); PG8_WAIT_L(0); PG8_BAR; PG8_MMA(0, 0, At, B0); PG8_MMA(0, 1, At, B1); PG8_BAR; PG8_SCHED;
            PG8_STAGE(PG8_SB(0, 0), b2, voffB); PG8_STAGE(PG8_SB(0, 1), b2 + hstep, voffB); PG8_STAGE(PG8_SA(0, 0), a2, voffA); PG8_LDA(At, 0, 1);
            PG8_WAIT_V(8); PG8_WAIT_L(0); PG8_BAR; PG8_MMA(1, 0, At, B0); PG8_MMA(1, 1, At, B1); PG8_BAR; PG8_SCHED;
            PG8_STAGE(PG8_SA(0, 1), a2 + hstep, voffA); PG8_LDB(B0, 1, 0); PG8_LDB(B1, 1, 1); PG8_SCHED; PG8_LDA(At, 1, 0);
            PG8_WAIT_V(8); PG8_WAIT_L(0); PG8_BAR; PG8_MMA(0, 0, At, B0); PG8_MMA(0, 1, At, B1); PG8_BAR; PG8_SCHED;
            PG8_STAGE(PG8_SB(1, 0), b3, voffB); PG8_STAGE(PG8_SB(1, 1), b3 + hstep, voffB); PG8_STAGE(PG8_SA(1, 0), a3, voffA); PG8_LDA(At, 1, 1);
            PG8_WAIT_V(8); PG8_WAIT_L(0); PG8_BAR; PG8_MMA(1, 0, At, B0); PG8_MMA(1, 1, At, B1); PG8_BAR; PG8_SCHED;
            } else {
            PG8_LDB(B0, 0, 0); PG8_SCHED; PG8_LDA(At, 0, 0); PG8_STAGE(PG8_SA(1, 1), a1 + hstep, voffA);
            PG8_WAIT_L(8); PG8_BAR; PG8_WAIT_L(0); PG8_MMA(0, 0, At, B0); PG8_BAR; PG8_SCHED;
            PG8_LDB(B1, 0, 1); PG8_STAGE(PG8_SB(0, 0), b2, voffB);
            PG8_BAR; PG8_WAIT_L(0); PG8_MMA(0, 1, At, B1); PG8_BAR;
            PG8_LDA(At, 0, 1); PG8_STAGE(PG8_SA(0, 0), a2, voffA);
            PG8_BAR; PG8_WAIT_L(0); PG8_MMA(1, 0, At, B0); PG8_BAR; PG8_SCHED;
            PG8_STAGE(PG8_SB(0, 1), b2 + hstep, voffB);
            PG8_WAIT_V(6); PG8_BAR; PG8_MMA(1, 1, At, B1); PG8_BAR;
            PG8_LDB(B0, 1, 0); PG8_SCHED; PG8_LDA(At, 1, 0); PG8_STAGE(PG8_SA(0, 1), a2 + hstep, voffA);
            PG8_WAIT_L(8); PG8_BAR; PG8_WAIT_L(0); PG8_MMA(0, 0, At, B0); PG8_BAR; PG8_SCHED;
            PG8_LDB(B1, 1, 1); PG8_STAGE(PG8_SB(1, 0), b3, voffB);
            PG8_BAR; PG8_WAIT_L(0); PG8_MMA(0, 1, At, B1); PG8_BAR;
            PG8_LDA(At, 1, 1); PG8_STAGE(PG8_SA(1, 0), a3, voffA);
            PG8_BAR; PG8_WAIT_L(0); PG8_MMA(1, 0, At, B0); PG8_BAR; PG8_SCHED;
            PG8_STAGE(PG8_SB(1, 1), b3 + hstep, voffB);
            PG8_WAIT_V(6); PG8_BAR; PG8_MMA(1, 1, At, B1); PG8_BAR;
            }
        }
        if constexpr (ALIGN_EPI) { if (wr == 0) PG8_BAR; }
        { int tz = threadIdx.x; asm volatile("" : "+v"(tz)); const int lz = tz & 63; E(acc, cur, nxt, has_next, ui & 1, wr, wc, lz & 15, lz >> 4); }
        if (!has_next) break;
#pragma unroll
        for (int a = 0; a < 2; ++a)
#pragma unroll
            for (int b = 0; b < 2; ++b)
#pragma unroll
                for (int m = 0; m < 4; ++m)
#pragma unroll
                    for (int n = 0; n < 2; ++n) acc[a][b][m][n] = (f32x4){0.f, 0.f, 0.f, 0.f};
        cur = nxt; cA = nA; cB = nB; ++ui;
        if constexpr (ALIGN_EPI) { if (wr == 1) PG8_BAR; }
    }
    PG8_WAIT_V(0);
    if constexpr (!ALIGN_EPI) { if (wr == 0) PG8_BAR; }
    PG8_BAR;
#undef PG8_SA
#undef PG8_SB
#undef PG8_STAGE
#undef PG8_LDA
#undef PG8_LDB
#undef PG8_MMA
#undef PG8_WAIT_V
#undef PG8_WAIT_L
#undef PG8_BAR
#undef PG8_SCHED
}
}

constexpr int NWAVES = 8;
constexpr int M = 16384, D = 4096, DIN = 10240, DFF = 16384, DEPTH = 4, NMOD = 6;
constexpr int HD = 128, NHEAD = 16, CHUNK = 128, GRID_W = 64, GRID_ROWS = M / GRID_W, WIN_R = 8, WIN_C = 16;
constexpr int RPB_R = 2 * WIN_R - 1, RPB_C = 2 * WIN_C - 1, RPB_N = RPB_R * RPB_C;
constexpr int O_U = 0, O_V = 2048, O_Q = 4096, O_K = 6144, O_VB = 8192;
static_assert(DIN == pg8::DIN_C, "DIN");

constexpr size_t MiB = 1u << 20;
constexpr size_t WS_CTL = 0, CTL_ZERO_BYTES = 1 * MiB;
constexpr size_t WS_COND = 1 * MiB;
constexpr size_t WS_WSB = 2 * MiB;
constexpr size_t WS_MODG = 4 * MiB;
constexpr size_t WS_GATE = WS_MODG + 256 * 1024;
constexpr size_t WS_SSQ = 5 * MiB;
constexpr size_t WS_BIAS1 = 6 * MiB;
constexpr size_t WS_BIAS3 = 7 * MiB;
constexpr size_t WS_WIN = 16 * MiB;
constexpr size_t WS_WOUT = WS_WIN + 320 * MiB;
constexpr size_t WS_W1 = WS_WOUT + 128 * MiB;
constexpr size_t WS_W2 = WS_W1 + 512 * MiB;
constexpr size_t WS_H = WS_W2 + 512 * MiB;
constexpr size_t WS_Z = WS_H + 128 * MiB;
constexpr size_t WS_CAT = WS_Z + 320 * MiB;
constexpr size_t WS_HID = WS_CAT + 128 * MiB;
constexpr size_t WS_END = WS_HID + 512 * MiB;
constexpr size_t WS_BP1 = WS_HID;
constexpr size_t WS_BP3 = WS_HID + 16 * MiB;
constexpr int CW_BAR = 4096;

constexpr int RING_OFF = 0, RING_BYTES = 131072;
constexpr int TAB_OFF = RING_BYTES;
constexpr int RTAB_OFF = TAB_OFF + 8192;
constexpr int BTAB_OFF = RTAB_OFF + 2048;
constexpr int LDSCTL_OFF = BTAB_OFF + 2048, MISC_OFF = LDSCTL_OFF + 320;
constexpr int LDS_BYTES = 147456;
static_assert(MISC_OFF + 128 <= LDS_BYTES, "LDS map");

#define GAS __attribute__((address_space(1)))
#define LAS __attribute__((address_space(3)))
typedef unsigned short bf16;
typedef unsigned v4u __attribute__((ext_vector_type(4)));
typedef unsigned v2u __attribute__((ext_vector_type(2)));
typedef float f32x4 __attribute__((ext_vector_type(4)));
typedef short bf16x8 __attribute__((ext_vector_type(8)));
typedef short v4i16_t __attribute__((ext_vector_type(4)));
typedef GAS unsigned gu32;
#define RLX_AGENT __ATOMIC_RELAXED, __HIP_MEMORY_SCOPE_AGENT
#define LDS_WAIT() asm volatile("s_waitcnt lgkmcnt(0)" ::: "memory")
#define VM_WAIT() asm volatile("s_waitcnt vmcnt(0)" ::: "memory")
__device__ __forceinline__ unsigned f2bf(float f) { unsigned u = __builtin_bit_cast(unsigned, f); return (u + 0x7fffu + ((u >> 16) & 1u)) >> 16; }
__device__ __forceinline__ unsigned pk2(float lo, float hi) { return pg8::cvt_pk_bf16(lo, hi); }
__device__ __forceinline__ float bflo(unsigned w) { return __builtin_bit_cast(float, w << 16); }
__device__ __forceinline__ float bfhi(unsigned w) { return __builtin_bit_cast(float, w & 0xffff0000u); }

#define XB_TMO      128
#define XB_XCNT(j)  (256  + 64 * (j))
#define XB_XSUB(j)  (1280 + 64 * (j))
#define XB_XGEN(j)  (2304 + 64 * (j))
#define XB_TOP      3328
#define XB_TOPGEN   3392
#define XCD_BAR_WORDS 3456
#define XB_SPIN_CAP (1u << 20)

__device__ __forceinline__ unsigned xb_ld(unsigned* p)              { return __hip_atomic_load(p, __ATOMIC_RELAXED, __HIP_MEMORY_SCOPE_AGENT); }
__device__ __forceinline__ unsigned xb_add(unsigned* p, unsigned v) { return __hip_atomic_fetch_add(p, v, __ATOMIC_RELAXED, __HIP_MEMORY_SCOPE_AGENT); }
__device__ __forceinline__ unsigned xb_xcc_id() { return (unsigned)__builtin_amdgcn_s_getreg((3 << 11) | 20) & 0xFu; }
#define XB_SPIN(cond, bar) do { unsigned _sp = 0; while (cond) { __builtin_amdgcn_s_sleep(1); \
    if ((++_sp & 255u) == 0u) { if (xb_ld(&(bar)[XB_TMO])) break; if (_sp > XB_SPIN_CAP) { atomicAdd(&(bar)[XB_TMO], 1u); break; } } } } while (0)

struct XcdBarrier { unsigned* bar; unsigned x; volatile LAS unsigned* st; };

__device__ __forceinline__ XcdBarrier xcd_barrier_post(unsigned* bar, volatile LAS unsigned* st) {
    XcdBarrier b; b.bar = bar; b.x = xb_xcc_id(); b.st = st;
    if (threadIdx.x == 0) (void)xb_add(&bar[XB_XCNT(b.x)], 1u);
    return b;
}
__device__ __forceinline__ void xcd_barrier_complete(unsigned* bar, unsigned x, unsigned& nloc, unsigned& nx) {
    const unsigned G = gridDim.x * gridDim.y * gridDim.z;
    unsigned sum, cnt, mine, sp = 0u;
    for (;;) {
        sum = 0u; cnt = 0u; mine = 0u;
#pragma unroll
        for (unsigned j = 0; j < 16; ++j) { const unsigned c = xb_ld(&bar[XB_XCNT(j)]); sum += c; cnt += (c > 0u) ? 1u : 0u; mine = (j == x) ? c : mine; }
        if (sum == G) break;
        __builtin_amdgcn_s_sleep(1);
        if ((++sp & 255u) == 0u) { if (xb_ld(&bar[XB_TMO])) break; if (sp > XB_SPIN_CAP) { atomicAdd(&bar[XB_TMO], 1u); break; } }
    }
    nloc = mine > 0u ? mine : 1u; nx = cnt > 0u ? cnt : 1u;
}
__device__ __forceinline__ void xcd_barrier(const XcdBarrier& b) {
    asm volatile("s_waitcnt vmcnt(0)" ::: "memory");
    __syncthreads();
    if (threadIdx.x == 0) {
        unsigned* bar = b.bar;
        __builtin_amdgcn_s_waitcnt(0);
        unsigned nloc = b.st[0], nx = b.st[1];
        if (nloc == 0u) { xcd_barrier_complete(bar, b.x, nloc, nx); b.st[0] = nloc; b.st[1] = nx; }
        const unsigned old = xb_add(&bar[XB_XSUB(b.x)], 1u);
        const unsigned gen = old / nloc;
        if (old + 1u == (gen + 1u) * nloc) {
            __builtin_amdgcn_fence(__ATOMIC_RELEASE, "agent");
            asm volatile("s_waitcnt vmcnt(0)" ::: "memory");
            const unsigned og = xb_add(&bar[XB_TOP], 1u);
            const unsigned tg = og / nx;
            if (og + 1u == (tg + 1u) * nx) xb_add(&bar[XB_TOPGEN], 1u);
            else XB_SPIN(xb_ld(&bar[XB_TOPGEN]) == tg, bar);
            __builtin_amdgcn_fence(__ATOMIC_ACQUIRE, "agent");
            xb_add(&bar[XB_XGEN(b.x)], 1u);
            asm volatile("s_waitcnt vmcnt(0)" ::: "memory");
        } else {
            XB_SPIN(xb_ld(&bar[XB_XGEN(b.x)]) == gen, bar);
            __builtin_amdgcn_fence(__ATOMIC_ACQUIRE, "agent");
            asm volatile("s_waitcnt vmcnt(0)" ::: "memory");
        }
    }
    __syncthreads();
}

struct Args { const float* in[17]; float* out; unsigned char* ws; int ph_lo, ph_hi; };
typedef const __attribute__((address_space(4))) Args* ArgsP;
__device__ __forceinline__ ArgsP opaque_args() { ArgsP p = (ArgsP)__builtin_amdgcn_kernarg_segment_ptr(); asm volatile("" : "+s"(p)); return p; }
enum { I_X = 0, I_C, I_WADA, I_BADA, I_TABLE, I_N1W, I_WIN, I_VNW, I_WS, I_BS, I_QNW, I_KNW, I_RPB, I_WOUT, I_N2W, I_W1, I_W2 };
struct Frame {
    LAS unsigned char* lds;
    int vcu, G;
};
#define OPAQUE_TID(t) int t = threadIdx.x; asm volatile("" : "+v"(t))

__device__ __forceinline__ float wave_sum(float v) {
#pragma unroll
    for (int o = 1; o < 64; o <<= 1) v += __shfl_xor(v, o);
    return v;
}

template <bool BIAS>
__device__ __forceinline__ void p0_transpose_item(const float* W, int K, int N, bf16* WT, LAS float* scr, int item, int lane, const float* sA, const float* sB, float* bpart, const float* nw) {
    const int nblk = N / 32, kb = item / nblk, nb = item % nblk, k0 = 64 * kb, n0 = 32 * nb;
    float sv = 0.f; if (BIAS) sv = sA[k0 + lane] + sB[k0 + lane];
#pragma unroll 8
    for (int i = 0; i < 32; ++i) { const int kk = 2 * i + (lane >> 5); scr[kk * 33 + (lane & 31)] = W[(size_t)(k0 + kk) * N + n0 + (lane & 31)]; }
    LDS_WAIT(); asm volatile("" ::: "memory");
    const int c = lane & 7;
    float gk[8];
#pragma unroll
    for (int i = 0; i < 8; ++i) gk[i] = 1.0f;
    if (BIAS) { const int kq = k0 + 8 * c; const f32x4 w0 = *(const GAS f32x4*)(nw + kq), w1 = *(const GAS f32x4*)(nw + kq + 4);
        const f32x4 a0 = *(const GAS f32x4*)(sA + D + kq) + *(const GAS f32x4*)(sB + D + kq), a1 = *(const GAS f32x4*)(sA + D + kq + 4) + *(const GAS f32x4*)(sB + D + kq + 4);
#pragma unroll
        for (int i = 0; i < 4; ++i) { gk[i] = w0[i] * (1.0f + a0[i]); gk[4 + i] = w1[i] * (1.0f + a1[i]); } }
#pragma unroll
    for (int j = 0; j < 4; ++j) { const int n = (lane >> 3) + 8 * j; const LAS float* s = scr + (8 * c) * 33 + n;
        v4u o; o.x = pk2(s[0 * 33] * gk[0], s[1 * 33] * gk[1]); o.y = pk2(s[2 * 33] * gk[2], s[3 * 33] * gk[3]); o.z = pk2(s[4 * 33] * gk[4], s[5 * 33] * gk[5]); o.w = pk2(s[6 * 33] * gk[6], s[7 * 33] * gk[7]);
        *(GAS v4u*)(WT + pg8::ioffB(n0 + n, k0 + 8 * c, N)) = o; }
    if (BIAS) {
        const int n = lane & 31, half = lane >> 5; const int svi = __builtin_bit_cast(int, sv); float bsum = 0.f;
#pragma unroll
        for (int kk = 0; kk < 32; ++kk) { const float se = __builtin_bit_cast(float, __builtin_amdgcn_readlane(svi, 2 * kk)), so = __builtin_bit_cast(float, __builtin_amdgcn_readlane(svi, 2 * kk + 1));
            bsum += (half ? so : se) * scr[(2 * kk + half) * 33 + n]; }
        bsum += __shfl_xor(bsum, 32);
        if (lane < 32) bpart[(size_t)kb * N + n0 + n] = bsum;
    }
    LDS_WAIT(); asm volatile("" ::: "memory");
}

__device__ __forceinline__ void p0a_cond(const Frame& F, ArgsP A) {
    OPAQUE_TID(tid);
    float* cond = (float*)(A->ws + WS_COND);
    for (int slab = F.vcu; slab < 256; slab += F.G) {
        const int q = tid % 24, kg = tid / 24, col0 = slab * 96 + 4 * q;
        const float* cvec = A->in[I_C]; const float* wada = A->in[I_WADA];
        f32x4 a = (f32x4){0.f, 0.f, 0.f, 0.f};
        if (tid < 504) {
#pragma unroll 4
            for (int k = kg; k < D; k += 21) { const float cv = cvec[k]; const float s = cv * __builtin_amdgcn_rcpf(1.0f + __expf(-cv));
                a += *(const GAS f32x4*)(wada + (size_t)k * (NMOD * D) + col0) * s; }
            *(LAS f32x4*)(F.lds + (size_t)(kg * 24 + q) * 16) = a;
        }
        __syncthreads();
        if (tid < 96) { float s = 0.f;
            for (int g = 0; g < 21; ++g) s += ((const LAS float*)F.lds)[(g * 24 + (tid >> 2)) * 4 + (tid & 3)];
            cond[slab * 96 + tid] = s + A->in[I_BADA][slab * 96 + tid]; }
        __syncthreads();
    }
    { const int gt = F.vcu * 512 + tid, NT = F.G * 512; const float* w_s = A->in[I_WS]; bf16* WSB = (bf16*)(A->ws + WS_WSB);
      for (int i = gt; i < DEPTH * NHEAD * CHUNK * CHUNK / 4; i += NT) { const f32x4 v = ((const GAS f32x4*)w_s)[i]; v2u o; o.x = pk2(v[0], v[1]); o.y = pk2(v[2], v[3]); ((GAS v2u*)WSB)[i] = o; } }
}

__device__ __forceinline__ void p0b_weights(const Frame& F, ArgsP A) {
    OPAQUE_TID(tid); const int lane = tid & 63, wave = __builtin_amdgcn_readfirstlane(tid >> 6);
    const float* cond = (const float*)(A->ws + WS_COND); const float* table = A->in[I_TABLE];
    { float* gate = (float*)(A->ws + WS_GATE);
      for (int i = F.vcu * 512 + tid; i < DEPTH * 2 * D; i += F.G * 512) { const int l = i / (2 * D), w = (i / D) & 1, cidx = i % D;
        gate[i] = cond[(3 * w + 2) * D + cidx] + table[((size_t)l * NMOD + 3 * w + 2) * D + cidx]; } }
    LAS float* scr = (LAS float*)(F.lds + RING_OFF + wave * 16384);
    const int gw = F.vcu * NWAVES + wave, NGW = F.G * NWAVES;
    constexpr int I_IN = (D / 64) * (DIN / 32), I_OUT = (D / 64) * (D / 32), I_1 = (D / 64) * (DFF / 32), I_2 = (DFF / 64) * (D / 32);
    constexpr int I_LAYER = I_IN + I_OUT + I_1 + I_2;
    for (int it = gw; it < DEPTH * I_LAYER; it += NGW) {
        const int l = it / I_LAYER; int r = it - l * I_LAYER;
        if (r < I_IN) { p0_transpose_item<true>(A->in[I_WIN] + (size_t)l * D * DIN, D, DIN, (bf16*)(A->ws + WS_WIN) + (size_t)l * DIN * D, scr, r, lane,
                                                cond, table + (size_t)l * NMOD * D, (float*)(A->ws + WS_BP1) + (size_t)l * 64 * DIN, A->in[I_N1W] + (size_t)l * D); continue; } r -= I_IN;
        if (r < I_OUT) { p0_transpose_item<false>(A->in[I_WOUT] + (size_t)l * D * D, D, D, (bf16*)(A->ws + WS_WOUT) + (size_t)l * D * D, scr, r, lane, nullptr, nullptr, nullptr, nullptr); continue; } r -= I_OUT;
        if (r < I_1) { p0_transpose_item<true>(A->in[I_W1] + (size_t)l * D * DFF, D, DFF, (bf16*)(A->ws + WS_W1) + (size_t)l * DFF * D, scr, r, lane,
                                               cond + 3 * D, table + ((size_t)l * NMOD + 3) * D, (float*)(A->ws + WS_BP3) + (size_t)l * 64 * DFF, A->in[I_N2W] + (size_t)l * D); continue; } r -= I_1;
        p0_transpose_item<false>(A->in[I_W2] + (size_t)l * DFF * D, DFF, D, (bf16*)(A->ws + WS_W2) + (size_t)l * D * DFF, scr, r, lane, nullptr, nullptr, nullptr, nullptr);
    }
}

__device__ __forceinline__ void p1_prep(const Frame& F, ArgsP A) {
    OPAQUE_TID(tid); const int lane = tid & 63, wave = __builtin_amdgcn_readfirstlane(tid >> 6);
    { const float* bp1 = (const float*)(A->ws + WS_BP1); const float* bp3 = (const float*)(A->ws + WS_BP3);
      float* b1 = (float*)(A->ws + WS_BIAS1); float* b3 = (float*)(A->ws + WS_BIAS3);
      for (int i = F.vcu * 512 + tid; i < DEPTH * (DIN + DFF); i += F.G * 512) {
        if (i < DEPTH * DIN) { const int l = i / DIN, n = i % DIN; const float* p = bp1 + (size_t)l * 64 * DIN + n; float s = 0.f;
            for (int kb = 0; kb < 64; ++kb) s += p[(size_t)kb * DIN]; b1[i] = s; }
        else { const int j = i - DEPTH * DIN, l = j / DFF, n = j % DFF; const float* p = bp3 + (size_t)l * 64 * DFF + n; float s = 0.f;
            for (int kb = 0; kb < 64; ++kb) s += p[(size_t)kb * DFF]; b3[j] = s; } } }
    const float* x = A->in[I_X]; bf16* H = (bf16*)(A->ws + WS_H); float* ssq = (float*)(A->ws + WS_SSQ);
    const int gw = F.vcu * NWAVES + wave, NGW = F.G * NWAVES;
    for (int m = gw; m < M; m += NGW) {
        const GAS f32x4* xr = (const GAS f32x4*)(x + (size_t)m * D) + lane;
        f32x4 v[16]; float s = 0.f;
#pragma unroll
        for (int j = 0; j < 16; ++j) { v[j] = xr[64 * j]; }
#pragma unroll
        for (int j = 0; j < 16; ++j) { s += (v[j][0] * v[j][0] + v[j][1] * v[j][1]) + (v[j][2] * v[j][2] + v[j][3] * v[j][3]); }
        s = wave_sum(s);
        const size_t hb0 = pg8::ioff(m, 4 * lane, M);
#pragma unroll
        for (int j = 0; j < 16; ++j) { const f32x4 h = v[j];
            v2u o; o.x = pk2(h[0], h[1]); o.y = pk2(h[2], h[3]); *(GAS v2u*)(H + hb0 + (size_t)j * 4 * pg8::IMG_KT) = o; }
        if (lane < 16) ssq[(size_t)m * 16 + lane] = (lane == 0) ? s : 0.f;
    }
    __syncthreads();
}

#define ZPLANE(Z_, pl) ((Z_) + (size_t)(pl) * M * HD)
constexpr int TROW = 272;
__device__ __forceinline__ bf16x8 tr_pair(const LAS unsigned char* p0, const LAS unsigned char* p1) {
    const v4i16_t lo = __builtin_amdgcn_ds_read_tr16_b64_v4i16((LAS v4i16_t*)p0);
    const v4i16_t hi = __builtin_amdgcn_ds_read_tr16_b64_v4i16((LAS v4i16_t*)p1);
    return __builtin_shufflevector(lo, hi, 0, 1, 2, 3, 4, 5, 6, 7);
}

__device__ __forceinline__ void gmlp_phase(const Frame& F, ArgsP A, int tid, int l) {
    LAS unsigned char* lds = F.lds + RING_OFF;
    const int lane = tid & 63, w = __builtin_amdgcn_readfirstlane(tid >> 6), li = lane & 15, g = lane >> 4, q = li >> 2, p = li & 3;
    const int dh = w & 3, ph = w >> 2;
    const bf16* Z = (const bf16*)(A->ws + WS_Z); bf16* CAT = (bf16*)(A->ws + WS_CAT); const bf16* WSB = (const bf16*)(A->ws + WS_WSB) + (size_t)l * NHEAD * CHUNK * CHUNK;
    const float* b_s = A->in[I_BS] + l * NHEAD * CHUNK;
    constexpr int NU = NHEAD * (M / CHUNK);
    const int upw = (NU + F.G - 1) / F.G;
    int u = F.vcu * upw; asm volatile("" : "+s"(u)); const int uend = min(u + upw, NU);
    const int ptok = tid >> 4, pch = tid & 15;
    const int prow = 64 * ph + li, dcol = 32 * dh + 4 * g;
    while (u < uend) {
        const int h = u >> 7, segend = min(uend, (h + 1) * 128);
        bf16x8 wsf[4][4]; float bs[4];
        { const bf16* wsp = WSB + ((size_t)h * CHUNK + prow) * CHUNK + 8 * g;
#pragma unroll
          for (int pbi = 0; pbi < 4; ++pbi) {
#pragma unroll
              for (int ks = 0; ks < 4; ++ks) wsf[pbi][ks] = *(const GAS bf16x8*)(wsp + (size_t)(16 * pbi) * CHUNK + 32 * ks);
              bs[pbi] = b_s[h * CHUNK + prow + 16 * pbi]; } }
        v4u vt[4];
        { const bf16* vsrc = ZPLANE(Z, 16 + h) + (size_t)((u & 127) * CHUNK + ptok) * HD + pch * 8;
#pragma unroll
          for (int j = 0; j < 4; ++j) vt[j] = *(const GAS v4u*)(vsrc + (size_t)(32 * j) * HD); }
        for (; u < segend; ++u) {
            const int n = u & 127;
#pragma unroll
            for (int j = 0; j < 4; ++j) *(LAS v4u*)(lds + (ptok + 32 * j) * TROW + pch * 16) = vt[j];
            __syncthreads();
            { const int nn = (u + 1 < segend) ? ((u + 1) & 127) : n;
              const bf16* vsrc = ZPLANE(Z, 16 + h) + (size_t)(nn * CHUNK + ptok) * HD + pch * 8;
#pragma unroll
              for (int j = 0; j < 4; ++j) vt[j] = *(const GAS v4u*)(vsrc + (size_t)(32 * j) * HD); }
            v2u uu[2][4];
            { const bf16* up = ZPLANE(Z, h) + ((size_t)n * CHUNK + prow) * HD + dcol;
#pragma unroll
              for (int dbi = 0; dbi < 2; ++dbi)
#pragma unroll
                  for (int pbi = 0; pbi < 4; ++pbi) uu[dbi][pbi] = *(const GAS v2u*)(up + (size_t)(16 * pbi) * HD + 16 * dbi); }
            f32x4 acc[2][4];
#pragma unroll
            for (int dbi = 0; dbi < 2; ++dbi)
#pragma unroll
                for (int pbi = 0; pbi < 4; ++pbi) acc[dbi][pbi] = (f32x4){0.f, 0.f, 0.f, 0.f};
#pragma unroll
            for (int ks = 0; ks < 4; ++ks) {
                const LAS unsigned char* base = lds + (32 * ks + 8 * g + q) * TROW + 64 * dh + 8 * p;
                const bf16x8 a0 = tr_pair(base, base + 4 * TROW), a1 = tr_pair(base + 32, base + 4 * TROW + 32);
#pragma unroll
                for (int pbi = 0; pbi < 4; ++pbi) { acc[0][pbi] = __builtin_amdgcn_mfma_f32_16x16x32_bf16(a0, wsf[pbi][ks], acc[0][pbi], 0, 0, 0);
                                                    acc[1][pbi] = __builtin_amdgcn_mfma_f32_16x16x32_bf16(a1, wsf[pbi][ks], acc[1][pbi], 0, 0, 0); }
            }
            { const size_t ob0 = pg8::ioff(n * CHUNK + prow, h * HD + dcol, M), ob1 = pg8::ioff(n * CHUNK + prow, h * HD + dcol + 16, M);
#pragma unroll
              for (int dbi = 0; dbi < 2; ++dbi)
#pragma unroll
                  for (int pbi = 0; pbi < 4; ++pbi) { const v2u x = uu[dbi][pbi]; const float b = bs[pbi]; const f32x4 a = acc[dbi][pbi];
                    const float o0 = bflo(x.x) * (a[0] + b), o1 = bfhi(x.x) * (a[1] + b), o2 = bflo(x.y) * (a[2] + b), o3 = bfhi(x.y) * (a[3] + b);
                    v2u o; o.x = pg8::cvt_pk_bf16(o0, o1); o.y = pg8::cvt_pk_bf16(o2, o3); *(GAS v2u*)(CAT + (dbi ? ob1 : ob0) + pbi * 1024) = o; } }
            __syncthreads();
        }
    }
}

constexpr int NA_VOFF = 64 * TROW, NA_BUF = 2 * 64 * TROW, NA_BIAS_OFF = 2 * NA_BUF, NA_STEPS = 12;
static_assert(NA_BIAS_OFF + 2 * 512 * 4 <= RING_BYTES, "NA LDS");
__device__ __forceinline__ void na_load_tile(v4u (&st)[4], const char* ub, unsigned voff) {
    st[0] = *(const GAS v4u*)(ub + voff); st[1] = *(const GAS v4u*)(ub + (size_t)32 * HD * 2 + voff);
    st[2] = *(const GAS v4u*)(ub + (size_t)16 * M * HD * 2 + voff); st[3] = *(const GAS v4u*)(ub + (size_t)16 * M * HD * 2 + (size_t)32 * HD * 2 + voff);
}
__device__ __forceinline__ void na_write_tile(LAS unsigned char* dst, const v4u (&st)[4]) {
    *(LAS v4u*)(dst) = st[0]; *(LAS v4u*)(dst + 32 * TROW) = st[1]; *(LAS v4u*)(dst + NA_VOFF) = st[2]; *(LAS v4u*)(dst + NA_VOFF + 32 * TROW) = st[3];
}
__device__ __forceinline__ void na_block(const LAS unsigned char* kbuf, const LAS unsigned char* vbuf, const bf16x8 (&qf)[4], f32x4 (&O)[8], float& m, float& lsum,
                                         const LAS float* brow, int vbits, int boff, int key0, int li, int g, int q, int p) {
    f32x4 S[2];
#pragma unroll
    for (int kb = 0; kb < 2; ++kb) { f32x4 a = (f32x4){0.f, 0.f, 0.f, 0.f};
#pragma unroll
        for (int ks = 0; ks < 4; ++ks) { const bf16x8 kf = *(const LAS bf16x8*)(kbuf + (key0 + 16 * kb + li) * TROW + 64 * ks + 16 * g); a = __builtin_amdgcn_mfma_f32_16x16x32_bf16(kf, qf[ks], a, 0, 0, 0); }
        S[kb] = a; }
    const LAS float* bp = brow + boff;
    float mx = -INFINITY;
#pragma unroll
    for (int kb = 0; kb < 2; ++kb)
#pragma unroll
        for (int e = 0; e < 4; ++e) { const int t = __builtin_amdgcn_sbfe(vbits, 4 * kb + e, 1);
            const float s = __builtin_bit_cast(float, (__builtin_bit_cast(int, S[kb][e] + bp[16 * kb + e]) & t) | (~t & (int)0xff800000)); S[kb][e] = s; mx = fmaxf(mx, s); }
    mx = fmaxf(mx, __shfl_xor(mx, 16)); mx = fmaxf(mx, __shfl_xor(mx, 32));
    if (__any(mx > m + 8.0f)) {
        const float mnew = fmaxf(m, mx), alpha = __builtin_amdgcn_exp2f(m - mnew); m = mnew; lsum *= alpha;
#pragma unroll
        for (int db = 0; db < 8; ++db) O[db] = O[db] * alpha;
    }
    float ps = 0.f;
#pragma unroll
    for (int kb = 0; kb < 2; ++kb)
#pragma unroll
        for (int e = 0; e < 4; ++e) { const float pe = __builtin_amdgcn_exp2f(S[kb][e] - m); S[kb][e] = pe; ps += pe; }
    lsum += ps;
    v4u pw; pw.x = pg8::cvt_pk_bf16(S[0][0], S[0][1]); pw.y = pg8::cvt_pk_bf16(S[0][2], S[0][3]); pw.z = pg8::cvt_pk_bf16(S[1][0], S[1][1]); pw.w = pg8::cvt_pk_bf16(S[1][2], S[1][3]);
    const bf16x8 pf = __builtin_bit_cast(bf16x8, pw);
    const LAS unsigned char* vb_ = vbuf + (key0 + 4 * g + q) * TROW + 8 * p;
#pragma unroll
    for (int db = 0; db < 8; ++db) { const bf16x8 a = tr_pair(vb_ + 32 * db, vb_ + 16 * TROW + 32 * db);
        O[db] = __builtin_amdgcn_mfma_f32_16x16x32_bf16(a, pf, O[db], 0, 0, 0); }
}
__device__ __forceinline__ void na_phase(const Frame& F, ArgsP A, int tid, int l) {
    LAS unsigned char* lds = F.lds + RING_OFF;
    const int lane = tid & 63, w = __builtin_amdgcn_readfirstlane(tid >> 6), li = lane & 15, g = lane >> 4, q = li >> 2, p = li & 3;
    const int rw = w >> 1, qh = w & 1;
    const bf16* Z = (const bf16*)(A->ws + WS_Z); bf16* CAT = (bf16*)(A->ws + WS_CAT);
    const float* rpb = A->in[I_RPB] + (size_t)l * NHEAD * RPB_N;
    constexpr int NRG = GRID_ROWS / 4, NU = NHEAD * NRG;
    int u = F.vcu; asm volatile("" : "+s"(u));
    if (u >= NU) return;
    const int c0 = 32 * qh + li, c1 = c0 + 16;
    const int cs0 = min(max(c0 - WIN_C / 2, 0), GRID_W - WIN_C), cs1 = min(max(c1 - WIN_C / 2, 0), GRID_W - WIN_C);
    const int k00 = qh ? 24 : 0, k01 = qh ? 32 : 8;
    int vb0 = 0, vb1 = 0;
#pragma unroll
    for (int i = 0; i < 8; ++i) { const int kc0 = k00 + 16 * (i >> 2) + 4 * g + (i & 3), kc1 = k01 + 16 * (i >> 2) + 4 * g + (i & 3);
        vb0 |= ((kc0 >= cs0) && (kc0 < cs0 + WIN_C)) ? (1 << i) : 0; vb1 |= ((kc1 >= cs1) && (kc1 < cs1 + WIN_C)) ? (1 << i) : 0; }
    const int bo0 = k00 + 4 * g - c0 + (WIN_C - 1), bo1 = k01 + 4 * g - c1 + (WIN_C - 1);
    const int sk = tid >> 4, sc = tid & 15;
    const unsigned st_voff = (unsigned)(sk * HD + sc * 8) * 2u;
    LAS unsigned char* st_lds = lds + sk * TROW + sc * 16;
    LAS float* btab = (LAS float*)(lds + NA_BIAS_OFF);
#define NA_TSRC(ru_, h_, j) ((const char*)(ZPLANE(Z, 48 + (h_)) + (size_t)(min((ru_) + (j), GRID_ROWS - 1) * GRID_W) * HD)), st_voff
#define NA_RS(r_) min(max((r_) - WIN_R / 2, 0), GRID_ROWS - WIN_R)
    int rg = u & (NRG - 1), h = u / NRG, ru = NA_RS(4 * rg), par = 0;
    v4u R[4][4]; bf16x8 qf0[4], qf1[4];
    na_load_tile(R[0], NA_TSRC(ru, h, 0)); na_load_tile(R[1], NA_TSRC(ru, h, 1)); na_load_tile(R[2], NA_TSRC(ru, h, 2)); na_load_tile(R[3], NA_TSRC(ru, h, 3));
    if (tid < RPB_N) btab[tid] = rpb[(size_t)h * RPB_N + tid] * 1.4426950408889634f;
    na_write_tile(st_lds, R[0]); na_load_tile(R[0], NA_TSRC(ru, h, 4));
    __syncthreads();
    for (;;) {
        const int un = u + F.G; const bool has_next = un < NU; const int uq = has_next ? un : u;
        const int rgn = uq & (NRG - 1), hn = uq / NRG, run = NA_RS(4 * rgn);
        const int r = 4 * rg + rw, rs = NA_RS(r);
        { const bf16* qp = ZPLANE(Z, 32 + h) + (size_t)(r * GRID_W + c0) * HD + 8 * g;
#pragma unroll
          for (int ks = 0; ks < 4; ++ks) { qf0[ks] = *(const GAS bf16x8*)(qp + 32 * ks); qf1[ks] = *(const GAS bf16x8*)(qp + (size_t)16 * HD + 32 * ks); } }
        const LAS float* bth = btab + par * 512;
        f32x4 O0[8], O1[8]; float m0 = -INFINITY, m1 = -INFINITY, l0 = 0.f, l1 = 0.f;
#pragma unroll
        for (int db = 0; db < 8; ++db) { O0[db] = (f32x4){0.f, 0.f, 0.f, 0.f}; O1[db] = (f32x4){0.f, 0.f, 0.f, 0.f}; }
#pragma unroll 1
        for (int jj = 0; jj < NA_STEPS; jj += 4) {
#pragma unroll
          for (int js = 0; js < 4; ++js) { const int j = jj + js;
            na_write_tile(st_lds + ((js + 1) & 1) * NA_BUF, R[(js + 1) & 3]);
            { const bool cur = (j + 5 < NA_STEPS); const int tj = cur ? j + 5 : j + 5 - NA_STEPS, tru = cur ? ru : run, th = cur ? h : hn;
              na_load_tile(R[(js + 1) & 3], NA_TSRC(tru, th, tj)); }
            if (j == 7 && tid < RPB_N) btab[(par ^ 1) * 512 + tid] = rpb[(size_t)hn * RPB_N + tid] * 1.4426950408889634f;
            const int il = ru + j - rs;
            if (il >= 0 && il < WIN_R) {
                const LAS unsigned char* kbuf = lds + (js & 1) * NA_BUF; const LAS unsigned char* vbuf = kbuf + NA_VOFF;
                const LAS float* brow = bth + (ru + j - r + (WIN_R - 1)) * RPB_C;
                na_block(kbuf, vbuf, qf0, O0, m0, l0, brow, vb0, bo0, k00, li, g, q, p);
                na_block(kbuf, vbuf, qf1, O1, m1, l1, brow, vb1, bo1, k01, li, g, q, p);
            }
            __syncthreads();
          }
        }
        l0 += __shfl_xor(l0, 16); l0 += __shfl_xor(l0, 32); l1 += __shfl_xor(l1, 16); l1 += __shfl_xor(l1, 32);
        const float i0 = 1.0f / l0, i1 = 1.0f / l1;
        const int orow = r * GRID_W + c0, ocol = (D / 2) + h * HD + 4 * g;
        const size_t ob0 = pg8::ioff(orow, ocol, M), ob1 = pg8::ioff(orow, ocol + 16, M);
#pragma unroll
        for (int db = 0; db < 8; ++db) {
            v2u o; o.x = pg8::cvt_pk_bf16(O0[db][0] * i0, O0[db][1] * i0); o.y = pg8::cvt_pk_bf16(O0[db][2] * i0, O0[db][3] * i0); *(GAS v2u*)(CAT + ((db & 1) ? ob1 : ob0) + (size_t)(db >> 2) * pg8::IMG_KT + ((db >> 1) & 1) * 512) = o;
            v2u o2; o2.x = pg8::cvt_pk_bf16(O1[db][0] * i1, O1[db][1] * i1); o2.y = pg8::cvt_pk_bf16(O1[db][2] * i1, O1[db][3] * i1); *(GAS v2u*)(CAT + ((db & 1) ? ob1 : ob0) + (size_t)(db >> 2) * pg8::IMG_KT + ((db >> 1) & 1) * 512 + 1024) = o2; }
        if (!has_next) break;
        u = un; rg = rgn; h = hn; ru = run; par ^= 1;
    }
#undef NA_TSRC
#undef NA_RS
    __syncthreads();
}

__device__ __forceinline__ void mixer_phase(const Frame& F, ArgsP A, int l) {
    OPAQUE_TID(tid);
    gmlp_phase(F, A, tid, l);
    na_phase(F, A, tid, l);
}

constexpr int N_PHASES = 3 + 5 * DEPTH;

__global__ void __launch_bounds__(NWAVES * 64, 2) enc_fwd(Args args) {
    extern __shared__ __attribute__((aligned(16))) unsigned char lds[];
    Frame F;
    F.lds = (LAS unsigned char*)lds;
    F.G = gridDim.x; { const int bx = blockIdx.x; F.vcu = (F.G % 8 == 0) ? (bx % 8) * (F.G / 8) + bx / 8 : bx; }
    { OPAQUE_TID(t0); for (int u = t0; u < (LDS_BYTES - LDSCTL_OFF) / 4; u += NWAVES * 64) ((LAS unsigned*)(F.lds + LDSCTL_OFF))[u] = 0u; }
    __syncthreads();
    unsigned* barw = (unsigned*)(args.ws + WS_CTL) + CW_BAR;
    XcdBarrier bar; bar.bar = barw; bar.x = 0; bar.st = nullptr;
    if (!MK_PER_PHASE) bar = xcd_barrier_post(barw, (volatile LAS unsigned*)(F.lds + MISC_OFF) + 8);

    const int lo = args.ph_lo, hi = args.ph_hi;
#define IN(k) (lo <= (k) && (k) < hi)
#define SEAM(k) do { if (IN(k) && IN((k) + 1)) xcd_barrier(bar); } while (0)

    if (IN(0)) { ArgsP A = opaque_args(); p0a_cond(F, A); } SEAM(0);
    if (IN(1)) { ArgsP A = opaque_args(); p0b_weights(F, A); } SEAM(1);
    if (IN(2)) { ArgsP A = opaque_args(); p1_prep(F, A); } SEAM(2);

#pragma unroll 1
    for (int l = 0; l < DEPTH; ++l) {
        const int pb = 3 + 5 * l;
        if (IN(pb + 0)) { ArgsP args = opaque_args();
            pg8::Gemm g{(const bf16*)(args->ws + WS_H), (const bf16*)(args->ws + WS_WIN) + (size_t)l * DIN * D, M, DIN, D}; pg8::StaticOrder S; S.init(M, DIN, F.G, (int)blockIdx.x);
            pg8::EpiIn E{(bf16*)(args->ws + WS_Z), args->in[I_VNW] + (size_t)l * NHEAD * HD, args->in[I_QNW] + (size_t)l * HD, args->in[I_KNW] + (size_t)l * HD,
                         pg8::RowScale{(const float*)(args->ws + WS_SSQ), (const float*)(args->ws + WS_BIAS1) + (size_t)l * DIN, (PG8_LAS float*)(F.lds + RTAB_OFF), (PG8_LAS float*)(F.lds + BTAB_OFF)}, (PG8_LAS float*)(F.lds + TAB_OFF)};
            pg8::gemm_phase<pg8::EpiIn, pg8::StaticOrder, true, true>(F.lds + RING_OFF, g, S, E);
        }
        SEAM(pb + 0);
        if (IN(pb + 1)) { ArgsP args = opaque_args(); mixer_phase(F, args, l); }
        SEAM(pb + 1);
        if (IN(pb + 2)) { ArgsP args = opaque_args();
            pg8::Gemm g{(const bf16*)(args->ws + WS_CAT), (const bf16*)(args->ws + WS_WOUT) + (size_t)l * D * D, M, D, D}; pg8::StaticOrder S; S.init(M, D, F.G, (int)blockIdx.x);
            pg8::EpiResid E{(const float*)nullptr, (bf16*)(args->ws + WS_H), (float*)nullptr, (const float*)(args->ws + WS_GATE) + (size_t)(2 * l) * D,
                            (float*)(args->ws + WS_SSQ), (PG8_LAS float*)(F.lds + TAB_OFF), D};
            pg8::gemm_phase<pg8::EpiResid, pg8::StaticOrder, true, true>(F.lds + RING_OFF, g, S, E);
        }
        SEAM(pb + 2);
        if (IN(pb + 3)) { ArgsP args = opaque_args();
            pg8::Gemm g{(const bf16*)(args->ws + WS_H), (const bf16*)(args->ws + WS_W1) + (size_t)l * DFF * D, M, DFF, D}; pg8::StaticOrder S; S.init(M, DFF, F.G, (int)blockIdx.x);
            pg8::EpiRelu2 E{(bf16*)(args->ws + WS_HID), DFF, pg8::RowScale{(const float*)(args->ws + WS_SSQ), (const float*)(args->ws + WS_BIAS3) + (size_t)l * DFF, (PG8_LAS float*)(F.lds + RTAB_OFF), (PG8_LAS float*)(F.lds + BTAB_OFF)}};
            pg8::gemm_phase<pg8::EpiRelu2, pg8::StaticOrder, true, true>(F.lds + RING_OFF, g, S, E);
        }
        SEAM(pb + 3);
        if (IN(pb + 4)) { ArgsP args = opaque_args();
            pg8::Gemm g{(const bf16*)(args->ws + WS_HID), (const bf16*)(args->ws + WS_W2) + (size_t)l * D * DFF, M, D, DFF}; pg8::StaticOrder S; S.init(M, D, F.G, (int)blockIdx.x);
            pg8::EpiResid E{(const float*)nullptr, (bf16*)(args->ws + WS_H), (l + 1 < DEPTH) ? (float*)nullptr : args->out, (const float*)(args->ws + WS_GATE) + (size_t)(2 * l + 1) * D,
                            (float*)(args->ws + WS_SSQ), (PG8_LAS float*)(F.lds + TAB_OFF), D};
            pg8::gemm_phase<pg8::EpiResid, pg8::StaticOrder, true, true>(F.lds + RING_OFF, g, S, E);
        }
        if (l + 1 < DEPTH) SEAM(pb + 4);
    }
#undef IN
#undef SEAM
}

extern "C" void kernel_launch(void* const* d_in, const int* in_sizes, int n_in, void* d_out, int out_size, void* d_ws, size_t ws_size, hipStream_t stream) {
    static int grid = 0;
    if (grid == 0) {
        if (n_in != 17 || in_sizes[0] != M * D || out_size != M * D || ws_size < WS_END) { fprintf(stderr, "kernel_launch: unexpected problem (n_in %d, in0 %d, out %d, ws %zu < %zu); nothing launched\n", n_in, n_in > 0 ? in_sizes[0] : -1, out_size, ws_size, (size_t)WS_END); grid = -1; return; }
        int dev = 0, cus = 0, per_cu = 0;
        if (hipGetDevice(&dev) != hipSuccess || hipDeviceGetAttribute(&cus, hipDeviceAttributeMultiprocessorCount, dev) != hipSuccess) { grid = -1; return; }
        if (hipFuncSetAttribute((const void*)enc_fwd, hipFuncAttributeMaxDynamicSharedMemorySize, LDS_BYTES) != hipSuccess) { fprintf(stderr, "kernel_launch: hipFuncSetAttribute failed\n"); grid = -1; return; }
        if (hipOccupancyMaxActiveBlocksPerMultiprocessor(&per_cu, (const void*)enc_fwd, NWAVES * 64, LDS_BYTES) != hipSuccess || per_cu < 1)
            fprintf(stderr, "kernel_launch: note: occupancy query reports %d workgroups per CU\n", per_cu);
        (void)hipGetLastError();
        grid = cus;
    }
    if (grid < 0) return;
    if (hipMemsetAsync((char*)d_ws + WS_CTL, 0, CTL_ZERO_BYTES, stream) != hipSuccess) { fprintf(stderr, "kernel_launch: hipMemsetAsync failed\n"); return; }
    Args a{};
    for (int i = 0; i < 17; ++i) a.in[i] = (const float*)d_in[i];
    a.out = (float*)d_out; a.ws = (unsigned char*)d_ws;
#if MK_PER_PHASE
    for (int ph = 0; ph < N_PHASES; ++ph) { a.ph_lo = ph; a.ph_hi = ph + 1; hipLaunchKernelGGL(enc_fwd, dim3(grid), dim3(NWAVES * 64), LDS_BYTES, stream, a); }
#else
    a.ph_lo = 0; a.ph_hi = N_PHASES;
    hipLaunchKernelGGL(enc_fwd, dim3(grid), dim3(NWAVES * 64), LDS_BYTES, stream, a);
#endif
    const hipError_t le = hipPeekAtLastError();
    if (le != hipSuccess) fprintf(stderr, "kernel_launch: launch failed: %s\n", hipGetErrorName(le));
}
```

```cpp
#include <hip/hip_runtime.h>
#include <cstdio>
#include <cstdint>

#ifndef MK_PER_PHASE
#define MK_PER_PHASE 0
#endif

namespace pg8 {
#define PG8_LAS __attribute__((address_space(3)))
typedef unsigned short bf16_t;
typedef short bf16x8 __attribute__((ext_vector_type(8)));
typedef float f32x4 __attribute__((ext_vector_type(4)));
typedef float f32x2 __attribute__((ext_vector_type(2)));
typedef unsigned u32x4 __attribute__((ext_vector_type(4)));
constexpr int BM = 256, BK = 64, HALF = 128, HTB = HALF * BK * 2  , STAGE_BYTES = 8 * HTB, NXCD = 8, WGM = 8;

__host__ __device__ __forceinline__ int lds_byte(int r, int c) { const int st = (r >> 4) * 2 + (c >> 5), rr = r & 15, cc = c & 31, ob = rr * 64 + cc * 2; return st * 1024 + (ob ^ (((ob >> 9) & 1) << 5)); }
__host__ __device__ __forceinline__ void stage_rc(int b, int& R, int& C) { const int st = b / 1024, sb = b % 1024, swz = sb ^ (((sb >> 9) & 1) << 5); R = (st >> 1) * 16 + swz / 64; C = (st & 1) * 32 + (swz % 64) / 2; }
__host__ __device__ __forceinline__ int perm32(int rho) { const int n = rho >> 4, i = rho & 15; return 8 * (i >> 2) + 4 * n + (i & 3); }

struct Unit { int pm, pn; };
struct Gemm { const bf16_t* A; const bf16_t* Bt; int M, N, K; int kalt = 0; };
__host__ __device__ __forceinline__ size_t ioff(int row, int col, int rows) { return ((size_t)(col >> 6) * (rows >> 7) + (row >> 7)) * 8192 + (size_t)(lds_byte(row & 127, col & 63) >> 1); }
constexpr size_t IMG_KT = (size_t)(16384 / 128) * 8192;
__host__ __device__ __forceinline__ int invperm32(int x) { return 16 * ((x >> 2) & 1) + 4 * (x >> 3) + (x & 3); }
__host__ __device__ __forceinline__ size_t ioffB(int n, int k, int N) { return ioff((n & ~31) | invperm32(n & 31), k, N); }

struct StaticOrder {
    int nM, nN, nwg, G, c;
    __host__ __device__ void init(int M, int N, int G_, int c_) { nM = M / BM; nN = N / BM; nwg = nM * nN; G = G_; c = c_; }
    __host__ __device__ bool next(int i, Unit& u) const {
        const long L = (long)i * G + c; if (L >= nwg) return false;
        int wgid = (int)L; { const int q = nwg / NXCD, r = nwg % NXCD, xcd = wgid % NXCD, off = wgid / NXCD; wgid = (xcd < r ? xcd * (q + 1) : r * (q + 1) + (xcd - r) * q) + off; }
        const int nig = WGM * nN, gid = wgid / nig, fm = gid * WGM, gsz = (nM - fm) < WGM ? (nM - fm) : WGM;
        u.pm = fm + ((wgid % nig) % gsz); u.pn = (wgid % nig) / gsz; return true;
    }
    __device__ __forceinline__ void a_ready(const Unit&) const {}
    __device__ __forceinline__ void done(const Unit&) const {}
};

__device__ __forceinline__ unsigned cvt_pk_bf16(float lo, float hi) { unsigned r; asm volatile("v_cvt_pk_bf16_f32 %0, %1, %2" : "=v"(r) : "v"(lo), "v"(hi)); return r; }

__device__ __forceinline__ float gelu_tanh(float x) {
    const float y = x * (1.0f + 0.044715f * x * x) * (-2.302208198f);
    return x * __builtin_amdgcn_rcpf(1.0f + __builtin_amdgcn_exp2f(y));
}


constexpr int DIN_C = 10240, ZM_C = 16384;
constexpr float QSCALE = 0.08838834764831845f * 1.4426950408889634f;
constexpr float RMS_EPS = 1e-6f;

struct RowScale {
    const float* ssq; const float* bias; PG8_LAS float* rtab; PG8_LAS float* btab;
    struct Regs { f32x4 a, b, c; };
    __device__ __forceinline__ void issue(const Unit& nx, int t, Regs& r) const {
        const f32x4* sp = (const f32x4*)(ssq + (size_t)(nx.pm * BM + (t >> 1)) * 16 + (t & 1) * 8);
        r.a = sp[0]; r.b = sp[1];
        r.c = *(const f32x4*)(bias + nx.pn * BM + 4 * (t & 63));
    }
    __device__ __forceinline__ void commit(int par, int t, const Regs& r) const {
        float s = ((r.a[0] + r.a[1]) + (r.a[2] + r.a[3])) + ((r.b[0] + r.b[1]) + (r.b[2] + r.b[3]));
        s += __shfl_xor(s, 1);
        if ((t & 1) == 0) rtab[par * BM + (t >> 1)] = __builtin_amdgcn_rsqf(s * (1.0f / 4096.0f) + RMS_EPS);
        if (t < 64) *(PG8_LAS f32x4*)&btab[par * BM + 4 * t] = r.c;
    }
    __device__ __forceinline__ void apply(f32x4 (&acc)[2][2][4][2], int par, int wr, int wc, int fr, int fq) const {
        f32x4 bv[2][2];
#pragma unroll
        for (int bj = 0; bj < 2; ++bj)
#pragma unroll
            for (int n = 0; n < 2; ++n) bv[bj][n] = *(const PG8_LAS f32x4*)&btab[par * BM + wc * 32 + 8 * fq + bj * HALF + 4 * n];
#pragma unroll
        for (int ai = 0; ai < 2; ++ai)
#pragma unroll
            for (int m = 0; m < 4; ++m) { const float rs = rtab[par * BM + ai * HALF + wr * 64 + m * 16 + fr];
#pragma unroll
                for (int bj = 0; bj < 2; ++bj)
#pragma unroll
                    for (int n = 0; n < 2; ++n) acc[ai][bj][m][n] = acc[ai][bj][m][n] * rs + bv[bj][n]; }
    }
};

struct EpiIn {
    static constexpr bool PERM = true, AFTER_DRAIN = false;
    bf16_t* Z; const float* vnw; const float* qnw; const float* knw; RowScale rsb; PG8_LAS float* tab;
    __device__ __forceinline__ void first(const Unit& u, int t) const { RowScale::Regs r; rsb.issue(u, t, r); rsb.commit(0, t, r); }
    __device__ __forceinline__ void operator()(f32x4 (&acc)[2][2][4][2], const Unit& u, const Unit& nx, bool has_next, int par, int wr, int wc, int fr, int fq) const {
        const int type = u.pn >> 3;
        const int row0 = u.pm * BM + wr * 64 + fr, col0 = u.pn * BM + wc * 32 + 8 * fq;
        const int t = (((wr << 2) | wc) << 6) | (fq << 4) | fr;
        rsb.apply(acc, par, wr, wc, fr, fq);
        asm volatile("" ::: "memory");
        RowScale::Regs pr; rsb.issue(has_next ? nx : u, t, pr);
        f32x4 wv[2][2];
        { const float* wp = (type == 1) ? (vnw + (u.pn - 8) * 256) : (type == 2 ? qnw : knw);
#pragma unroll
          for (int bj = 0; bj < 2; ++bj) { const float* w = wp + (type == 1 ? bj * HALF : 0) + wc * 32 + 8 * fq;
              wv[bj][0] = *(const f32x4*)w; wv[bj][1] = *(const f32x4*)(w + 4); } }
        if (type <= 1) {
#pragma unroll
            for (int ai = 0; ai < 2; ++ai)
#pragma unroll
                for (int bj = 0; bj < 2; ++bj)
#pragma unroll
                    for (int m = 0; m < 4; ++m)
#pragma unroll
                        for (int n = 0; n < 2; ++n)
#pragma unroll
                            for (int j = 0; j < 4; ++j) acc[ai][bj][m][n][j] = gelu_tanh(acc[ai][bj][m][n][j]);
        }
        if (type >= 1 && type <= 3) {
#pragma unroll
            for (int ai = 0; ai < 2; ++ai)
#pragma unroll
                for (int m = 0; m < 4; ++m)
#pragma unroll
                    for (int bj = 0; bj < 2; ++bj) {
                        const f32x4 a = acc[ai][bj][m][0], b = acc[ai][bj][m][1];
                        float s = (a[0] * a[0] + a[1] * a[1]) + (a[2] * a[2] + a[3] * a[3]) + (b[0] * b[0] + b[1] * b[1]) + (b[2] * b[2] + b[3] * b[3]);
                        s += __shfl_xor(s, 16); s += __shfl_xor(s, 32);
                        if (fq == 0) tab[((ai * HALF + wr * 64 + m * 16 + fr) * 2 + bj) * 4 + wc] = s;
                    }
            asm volatile("s_waitcnt lgkmcnt(0)" ::: "memory"); __builtin_amdgcn_s_barrier(); asm volatile("" ::: "memory");
            const float wmul = (type == 2) ? QSCALE : 1.0f;
#pragma unroll
            for (int ai = 0; ai < 2; ++ai)
#pragma unroll
                for (int m = 0; m < 4; ++m) {
#pragma unroll
                    for (int bj = 0; bj < 2; ++bj) {
                        const f32x4 p = *(const PG8_LAS f32x4*)&tab[((ai * HALF + wr * 64 + m * 16 + fr) * 2 + bj) * 4];
                        const float rstd = __builtin_amdgcn_rsqf(((p[0] + p[1]) + (p[2] + p[3])) * (1.0f / 128.0f) + RMS_EPS);
                        acc[ai][bj][m][0] = acc[ai][bj][m][0] * (wv[bj][0] * (rstd * wmul)); acc[ai][bj][m][1] = acc[ai][bj][m][1] * (wv[bj][1] * (rstd * wmul));
                    }
                    asm volatile("" ::: "memory");
                }
        }
        rsb.commit(par ^ 1, t, pr);
        asm volatile("" ::: "memory");
#pragma unroll
        for (int ai = 0; ai < 2; ++ai)
#pragma unroll
            for (int m = 0; m < 4; ++m) { bf16_t* rowp = Z + ((size_t)(u.pn * 2) * ZM_C + (size_t)(row0 + ai * HALF + m * 16)) * HALF + wc * 32 + 8 * fq;
#pragma unroll
                for (int bj = 0; bj < 2; ++bj) { const f32x4 v0 = acc[ai][bj][m][0], v1 = acc[ai][bj][m][1];
                    u32x4 w; w.x = cvt_pk_bf16(v0[0], v0[1]); w.y = cvt_pk_bf16(v0[2], v0[3]); w.z = cvt_pk_bf16(v1[0], v1[1]); w.w = cvt_pk_bf16(v1[2], v1[3]);
                    *(u32x4*)(rowp + (size_t)bj * ZM_C * HALF) = w; }
                asm volatile("" ::: "memory"); }
    }
};

struct EpiResid {
    static constexpr bool PERM = true, AFTER_DRAIN = false;
    const float* xin32; bf16_t* xb; float* out32; const float* gate; float* ssq; PG8_LAS float* tab; int ldc;
    __device__ __forceinline__ void first(const Unit&, int) const {}
    template <bool OUT32>
    __device__ __forceinline__ void body(f32x4 (&acc)[2][2][4][2], size_t off0, int irow0, int icol0, int wr, int wc, int fr, int fq) const {
        f32x4 gt[2][2];
#pragma unroll
        for (int bj = 0; bj < 2; ++bj)
#pragma unroll
            for (int n = 0; n < 2; ++n) gt[bj][n] = *(const f32x4*)(gate + icol0 + bj * HALF + 4 * n);
        const size_t ib0 = ioff(irow0, icol0, ZM_C);
        u32x4 xh[8][2];
#pragma unroll
        for (int gi = 0; gi < 8; ++gi)
#pragma unroll
            for (int bj = 0; bj < 2; ++bj) xh[gi][bj] = *(const u32x4*)(xb + ib0 + (size_t)bj * 2 * IMG_KT + (gi >> 2) * 8192 + (gi & 3) * 1024);
#pragma unroll
        for (int gi = 0; gi < 8; ++gi) { const int ai = gi >> 2, m = gi & 3; const size_t off = off0 + (size_t)(ai * HALF + m * 16) * ldc;
            float sq = 0.f;
#pragma unroll
            for (int bj = 0; bj < 2; ++bj) { f32x4 xn[2]; const u32x4 h = xh[gi][bj];
                xn[0] = (f32x4){__builtin_bit_cast(float, h.x << 16), __builtin_bit_cast(float, h.x & 0xffff0000u), __builtin_bit_cast(float, h.y << 16), __builtin_bit_cast(float, h.y & 0xffff0000u)};
                xn[1] = (f32x4){__builtin_bit_cast(float, h.z << 16), __builtin_bit_cast(float, h.z & 0xffff0000u), __builtin_bit_cast(float, h.w << 16), __builtin_bit_cast(float, h.w & 0xffff0000u)};
#pragma unroll
                for (int n = 0; n < 2; ++n) { xn[n] = xn[n] + gt[bj][n] * acc[ai][bj][m][n];
                    if (OUT32) *(f32x4*)(out32 + off + bj * HALF + 4 * n) = xn[n];
                    else sq += (xn[n][0] * xn[n][0] + xn[n][1] * xn[n][1]) + (xn[n][2] * xn[n][2] + xn[n][3] * xn[n][3]); }
                if (!OUT32) { u32x4 w; w.x = cvt_pk_bf16(xn[0][0], xn[0][1]); w.y = cvt_pk_bf16(xn[0][2], xn[0][3]); w.z = cvt_pk_bf16(xn[1][0], xn[1][1]); w.w = cvt_pk_bf16(xn[1][2], xn[1][3]);
                    *(u32x4*)(xb + ib0 + (size_t)bj * 2 * IMG_KT + ai * 8192 + m * 1024) = w; } }
            if (!OUT32) { sq += __shfl_xor(sq, 16); sq += __shfl_xor(sq, 32); if (fq == 0) tab[(ai * HALF + wr * 64 + m * 16 + fr) * 4 + wc] = sq; }
        }
    }
    __device__ __forceinline__ void operator()(f32x4 (&acc)[2][2][4][2], const Unit& u, const Unit&, bool, int, int wr, int wc, int fr, int fq) const {
        const int row0 = u.pm * BM + wr * 64 + fr, col0 = u.pn * BM + wc * 32 + 8 * fq;
        const size_t off0 = (size_t)row0 * ldc + col0;
        if (__builtin_amdgcn_readfirstlane((int)(out32 != nullptr))) body<true>(acc, off0, row0, col0, wr, wc, fr, fq);
        else body<false>(acc, off0, row0, col0, wr, wc, fr, fq);
        if (out32 == nullptr) {
            asm volatile("s_waitcnt lgkmcnt(0)" ::: "memory"); __builtin_amdgcn_s_barrier(); asm volatile("" ::: "memory");
            const int t = (((wr << 2) | wc) << 6) | (fq << 4) | fr;
            if (t < BM) { const f32x4 p = *(const PG8_LAS f32x4*)&tab[t * 4]; ssq[(size_t)(u.pm * BM + t) * 16 + u.pn] = (p[0] + p[1]) + (p[2] + p[3]); }
        }
    }
};

struct EpiRelu2 {
    static constexpr bool PERM = true, AFTER_DRAIN = false;
    bf16_t* O; int ldc; RowScale rsb;
    __device__ __forceinline__ void first(const Unit& u, int t) const { RowScale::Regs r; rsb.issue(u, t, r); rsb.commit(0, t, r); }
    __device__ __forceinline__ void operator()(f32x4 (&acc)[2][2][4][2], const Unit& u, const Unit& nx, bool has_next, int par, int wr, int wc, int fr, int fq) const {
        const int row0 = u.pm * BM + wr * 64 + fr, col0 = u.pn * BM + wc * 32 + 8 * fq;
        const int t = (((wr << 2) | wc) << 6) | (fq << 4) | fr;
        rsb.apply(acc, par, wr, wc, fr, fq);
        asm volatile("" ::: "memory");
        RowScale::Regs pr; rsb.issue(has_next ? nx : u, t, pr);
#pragma unroll
        for (int ai = 0; ai < 2; ++ai)
#pragma unroll
            for (int bj = 0; bj < 2; ++bj)
#pragma unroll
                for (int m = 0; m < 4; ++m)
#pragma unroll
                    for (int n = 0; n < 2; ++n)
#pragma unroll
                        for (int j = 0; j < 4; ++j) { const float a = fmaxf(acc[ai][bj][m][n][j], 0.f); acc[ai][bj][m][n][j] = a * a; }
        rsb.commit(par ^ 1, t, pr);
        asm volatile("" ::: "memory");
        const size_t ib0 = ioff(row0, col0, ZM_C);
#pragma unroll
        for (int ai = 0; ai < 2; ++ai)
#pragma unroll
            for (int m = 0; m < 4; ++m) {
#pragma unroll
                for (int bj = 0; bj < 2; ++bj) { const f32x4 v0 = acc[ai][bj][m][0], v1 = acc[ai][bj][m][1];
                    u32x4 w; w.x = cvt_pk_bf16(v0[0], v0[1]); w.y = cvt_pk_bf16(v0[2], v0[3]); w.z = cvt_pk_bf16(v1[0], v1[1]); w.w = cvt_pk_bf16(v1[2], v1[3]);
                    *(u32x4*)(O + ib0 + (size_t)bj * 2 * IMG_KT + ai * 8192 + m * 1024) = w; } }
    }
};

template <class Epi, class Sched, bool ALIGN_EPI = false, bool SP2 = false>
__device__ __forceinline__ void gemm_phase(PG8_LAS unsigned char* lds, const Gemm g, const Sched& S, const Epi& E) {
    int tid = threadIdx.x; asm volatile("" : "+v"(tid));
    __builtin_amdgcn_s_waitcnt(0);
    const int wid = __builtin_amdgcn_readfirstlane(tid >> 6), lane = tid & 63, wr = wid >> 2, wc = wid & 3, fr = lane & 15, fq = lane >> 4;
    const int K = g.K, nt = K / BK;
    static_assert(Epi::PERM, "the weight copies are written in the PERM row order");
    unsigned voffA[2], voffB[2];
#pragma unroll
    for (int i = 0; i < 2; ++i) { voffA[i] = (unsigned)(tid * 16 + i * 8192); voffB[i] = voffA[i]; }
    const long kstepA0 = (long)g.M * BK * 2, kstepB0 = (long)g.N * BK * 2;
    const long kspanA = (long)(nt - 1) * kstepA0, kspanB = (long)(nt - 1) * kstepB0;
#define PG8_KREV(i) (g.kalt && (((i) & 1) == 0))
    long kstepA = PG8_KREV(0) ? -kstepA0 : kstepA0, kstepB = PG8_KREV(0) ? -kstepB0 : kstepB0;
    const size_t hstep = (size_t)HALF * BK * 2;
    const size_t tstep = 2 * hstep;
    const unsigned ldsw = (unsigned)wid * 1024u;
    const unsigned ldsbase = (unsigned)(size_t)lds;
    const int aoff = lds_byte(wr * 64 + fr, fq * 8), boff = lds_byte(wc * 32 + fr, fq * 8);
#define PG8_SA(b, h) (((b) * 2 + (h)) * HTB)
#define PG8_SB(b, h) ((4 + (b) * 2 + (h)) * HTB)
#define PG8_STAGE(bufoff, gbase, voff) do { _Pragma("unroll") for (int _i = 0; _i < 2; ++_i) { \
        const unsigned _m0 = (unsigned)__builtin_amdgcn_readfirstlane((int)(ldsbase + (unsigned)(bufoff) + ldsw + _i * 8192)); \
        asm volatile("s_mov_b32 m0, %2\n\ts_nop 0\n\tglobal_load_lds_dwordx4 %0, %1" :: "v"((voff)[_i]), "s"(gbase), "s"(_m0) : "memory", "m0"); } } while (0)
#define PG8_LDA(dst, b, h) do { _Pragma("unroll") for (int m = 0; m < 4; ++m) _Pragma("unroll") for (int k = 0; k < 2; ++k) dst[m][k] = *(const PG8_LAS bf16x8*)(lds + PG8_SA(b, h) + aoff + m * 2048 + k * 1024); } while (0)
#define PG8_LDB(dst, b, h) do { _Pragma("unroll") for (int n = 0; n < 2; ++n) _Pragma("unroll") for (int k = 0; k < 2; ++k) dst[n][k] = *(const PG8_LAS bf16x8*)(lds + PG8_SB(b, h) + boff + n * 2048 + k * 1024); } while (0)
#define PG8_MMA(ai, bj, At, Bt) do { __builtin_amdgcn_s_setprio(1); _Pragma("unroll") for (int m = 0; m < 4; ++m) _Pragma("unroll") for (int n = 0; n < 2; ++n) _Pragma("unroll") for (int k = 0; k < 2; ++k) \
        acc[ai][bj][m][n] = __builtin_amdgcn_mfma_f32_16x16x32_bf16(Bt[n][k], At[m][k], acc[ai][bj][m][n], 0, 0, 0); __builtin_amdgcn_s_setprio(0); } while (0)
#define PG8_WAIT_V(n) asm volatile("s_waitcnt vmcnt(" #n ")" ::: "memory")
#define PG8_WAIT_L(n) asm volatile("s_waitcnt lgkmcnt(" #n ")" ::: "memory")
#define PG8_BAR __builtin_amdgcn_s_barrier()
#define PG8_SCHED __builtin_amdgcn_sched_barrier(0)
    Unit cur, nxt; int ui = 0;
    if (!S.next(0, cur)) return;
    f32x4 acc[2][2][4][2];
#pragma unroll
    for (int a = 0; a < 2; ++a)
#pragma unroll
        for (int b = 0; b < 2; ++b)
#pragma unroll
            for (int m = 0; m < 4; ++m)
#pragma unroll
                for (int n = 0; n < 2; ++n) acc[a][b][m][n] = (f32x4){0.f, 0.f, 0.f, 0.f};
    bf16x8 At[4][2], B0[2][2], B1[2][2];
    const char* cA = (const char*)g.A + (size_t)cur.pm * tstep + (PG8_KREV(0) ? kspanA : 0); const char* cB = (const char*)g.Bt + (size_t)cur.pn * tstep + (PG8_KREV(0) ? kspanB : 0);
    S.a_ready(cur);
    E.first(cur, tid);
    if constexpr (SP2) {
        PG8_STAGE(PG8_SB(0, 0), cB, voffB); PG8_STAGE(PG8_SB(0, 1), cB + hstep, voffB); PG8_STAGE(PG8_SA(0, 0), cA, voffA); PG8_STAGE(PG8_SA(0, 1), cA + hstep, voffA);
        if (wr == 1) PG8_BAR;
        PG8_WAIT_V(2); PG8_BAR;
        PG8_STAGE(PG8_SB(1, 0), cB + kstepB, voffB); PG8_STAGE(PG8_SA(1, 0), cA + kstepA, voffA); PG8_STAGE(PG8_SB(1, 1), cB + hstep + kstepB, voffB);
        PG8_WAIT_V(6); PG8_BAR;
    } else {
        PG8_STAGE(PG8_SB(0, 0), cB, voffB); PG8_STAGE(PG8_SA(0, 0), cA, voffA); PG8_STAGE(PG8_SB(0, 1), cB + hstep, voffB); PG8_STAGE(PG8_SA(0, 1), cA + hstep, voffA);
        if (wr == 1) PG8_BAR;
        PG8_WAIT_V(4); PG8_BAR;
        PG8_STAGE(PG8_SB(1, 0), cB + kstepB, voffB); PG8_STAGE(PG8_SA(1, 0), cA + kstepA, voffA); PG8_STAGE(PG8_SB(1, 1), cB + hstep + kstepB, voffB);
        PG8_WAIT_V(6); PG8_BAR;
    }
    for (;;) {
        const bool has_next = S.next(ui + 1, nxt);
        const bool nrev = has_next ? PG8_KREV(ui + 1) : PG8_KREV(ui);
        const long nstepA = nrev ? -kstepA0 : kstepA0, nstepB = nrev ? -kstepB0 : kstepB0;
        const char* nA = has_next ? (const char*)g.A + (size_t)nxt.pm * tstep + (nrev ? kspanA : 0) : cA; const char* nB = has_next ? (const char*)g.Bt + (size_t)nxt.pn * tstep + (nrev ? kspanB : 0) : cB;
        for (int t = 0; t < nt; t += 2) {
            const bool last = (t == nt - 2);
            const char* a1 = cA + (long)(t + 1) * kstepA;
            const char* a2 = last ? nA : cA + (long)(t + 2) * kstepA; const char* b2 = last ? nB : cB + (long)(t + 2) * kstepB;
            const char* a3 = a2 + (last ? nstepA : kstepA); const char* b3 = b2 + (last ? nstepB : kstepB);
            if (last && has_next) S.a_ready(nxt);
            if constexpr (SP2) {
            PG8_LDB(B0, 0, 0); PG8_LDB(B1, 0, 1); PG8_SCHED; PG8_LDA(At, 0, 0); PG8_STAGE(PG8_SA(1, 1), a1 + hstep, voffA);
            PG8_WAIT_V(8); PG8_WAIT_L(0); PG8_BAR; PG8_MMA(0, 0, At, B0); PG8_MMA(0, 1, At, B1); PG8_BAR; PG8_SCHED;
            PG8_LDA(At, 0, 1); PG8_STAGE(PG8_SB(0, 0), b2, voffB); PG8_STAGE(PG8_SB(0, 1), b2 + hstep, voffB); PG8_STAGE(PG8_SA(0, 0), a2, voffA);
            PG8_WAIT_V(8); PG8_WAIT_L(0); PG8_BAR; PG8_MMA(1, 0, At, B0); PG8_MMA(1, 1, At, B1); PG8_BAR; PG8_SCHED;
            PG8_LDB(B0, 1, 0); PG8_LDB(B1, 1, 1); PG8_SCHED; PG8_LDA(At, 1, 0); PG8_STAGE(PG8_SA(0, 1), a2 + hstep, voffA);
            PG8_WAIT_V(8); PG8_WAIT_L(0); PG8_BAR; PG8_MMA(0, 0, At, B0); PG8_MMA(0, 1, At, B1); PG8_BAR; PG8_SCHED;
            PG8_LDA(At, 1, 1); PG8_STAGE(PG8_SB(1, 0), b3, voffB); PG8_STAGE(PG8_SB(1, 1), b3 + hstep, voffB); PG8_STAGE(PG8_SA(1, 0), a3, voffA);
            PG8_WAIT_V(8); PG8_WAIT_L(0); PG8_BAR; PG8_MMA(1, 0, At, B0); PG8_MMA(1, 1, At, B1); PG8_BAR; PG8_SCHED;
            } else {
            PG8_LDB(B0, 0, 0); PG8_SCHED; PG8_LDA(At, 0, 0); PG8_STAGE(PG8_SA(1, 1), a1 + hstep, voffA);
            PG8_WAIT_L(8); PG8_BAR; PG8_WAIT_L(0); PG8_MMA(0, 0, At, B0); PG8_BAR; PG8_SCHED;
            PG8_LDB(B1, 0, 1); PG8_STAGE(PG8_SB(0, 0), b2, voffB);
            PG8_BAR; PG8_WAIT_L(0); PG8_MMA(0, 1, At, B1); PG8_BAR;
            PG8_LDA(At, 0, 1); PG8_STAGE(PG8_SA(0, 0), a2, voffA);
            PG8_BAR; PG8_WAIT_L(0); PG8_MMA(1, 0, At, B0); PG8_BAR; PG8_SCHED;
            PG8_STAGE(PG8_SB(0, 1), b2 + hstep, voffB);
            PG8_WAIT_V(6); PG8_BAR; PG8_MMA(1, 1, At, B1); PG8_BAR;
            PG8_LDB(B0, 1, 0); PG8_SCHED; PG8_LDA(At, 1, 0); PG8_STAGE(PG8_SA(0, 1), a2 + hstep, voffA);
            PG8_WAIT_L(8); PG8_BAR; PG8_WAIT_L(0); PG8_MMA(0, 0, At, B0); PG8_BAR; PG8_SCHED;
            PG8_LDB(B1, 1, 1); PG8_STAGE(PG8_SB(1, 0), b3, voffB);
            PG8_BAR; PG8_WAIT_L(0); PG8_MMA(0, 1, At, B1); PG8_BAR;
            PG8_LDA(At, 1, 1); PG8_STAGE(PG8_SA(1, 0), a3, voffA);
            PG8_BAR; PG8_WAIT_L(0); PG8_MMA(1, 0, At, B0); PG8_BAR; PG8_SCHED;
            PG8_STAGE(PG8_SB(1, 1), b3 + hstep, voffB);
            PG8_WAIT_V(6); PG8_BAR; PG8_MMA(1, 1, At, B1); PG8_BAR;
            }
        }
        if constexpr (ALIGN_EPI) { if (wr == 0) PG8_BAR; }
        { int tz = threadIdx.x; asm volatile("" : "+v"(tz)); const int lz = tz & 63; E(acc, cur, nxt, has_next, ui & 1, wr, wc, lz & 15, lz >> 4); }
        if (!has_next) break;
#pragma unroll
        for (int a = 0; a < 2; ++a)
#pragma unroll
            for (int b = 0; b < 2; ++b)
#pragma unroll
                for (int m = 0; m < 4; ++m)
#pragma unroll
                    for (int n = 0; n < 2; ++n) acc[a][b][m][n] = (f32x4){0.f, 0.f, 0.f, 0.f};
        cur = nxt; cA = nA; cB = nB; kstepA = nstepA; kstepB = nstepB; ++ui;
        if constexpr (ALIGN_EPI) { if (wr == 1) PG8_BAR; }
    }
    PG8_WAIT_V(0);
    if constexpr (!ALIGN_EPI) { if (wr == 0) PG8_BAR; }
    PG8_BAR;
#undef PG8_KREV
#undef PG8_SA
#undef PG8_SB
#undef PG8_STAGE
#undef PG8_LDA
#undef PG8_LDB
#undef PG8_MMA
#undef PG8_WAIT_V
#undef PG8_WAIT_L
#undef PG8_BAR
#undef PG8_SCHED
}
}

constexpr int NWAVES = 8;
constexpr int M = 16384, D = 4096, DIN = 10240, DFF = 16384, DEPTH = 4, NMOD = 6;
constexpr int HD = 128, NHEAD = 16, CHUNK = 128, GRID_W = 64, GRID_ROWS = M / GRID_W, WIN_R = 8, WIN_C = 16;
constexpr int RPB_R = 2 * WIN_R - 1, RPB_C = 2 * WIN_C - 1, RPB_N = RPB_R * RPB_C;
constexpr int O_U = 0, O_V = 2048, O_Q = 4096, O_K = 6144, O_VB = 8192;
static_assert(DIN == pg8::DIN_C, "DIN");

constexpr size_t MiB = 1u << 20;
constexpr size_t WS_CTL = 0, CTL_ZERO_BYTES = 1 * MiB;
constexpr size_t WS_COND = 1 * MiB;
constexpr size_t WS_WSB = 2 * MiB;
constexpr size_t WS_MODG = 4 * MiB;
constexpr size_t WS_GATE = WS_MODG + 256 * 1024;
constexpr size_t WS_SSQ = 5 * MiB;
constexpr size_t WS_BIAS1 = 6 * MiB;
constexpr size_t WS_BIAS3 = 7 * MiB;
constexpr size_t WS_WIN = 16 * MiB;
constexpr size_t WS_WOUT = WS_WIN + 320 * MiB;
constexpr size_t WS_W1 = WS_WOUT + 128 * MiB;
constexpr size_t WS_W2 = WS_W1 + 512 * MiB;
constexpr size_t WS_H = WS_W2 + 512 * MiB;
constexpr size_t WS_Z = WS_H + 128 * MiB;
constexpr size_t WS_CAT = WS_Z + 320 * MiB;
constexpr size_t WS_HID = WS_CAT + 128 * MiB;
constexpr size_t WS_END = WS_HID + 512 * MiB;
constexpr size_t WS_BP1 = WS_HID;
constexpr size_t WS_BP3 = WS_HID + 16 * MiB;
constexpr int CW_BAR = 4096;

constexpr int RING_OFF = 0, RING_BYTES = 131072;
constexpr int TAB_OFF = RING_BYTES;
constexpr int RTAB_OFF = TAB_OFF + 8192;
constexpr int BTAB_OFF = RTAB_OFF + 2048;
constexpr int LDSCTL_OFF = BTAB_OFF + 2048, MISC_OFF = LDSCTL_OFF + 320;
constexpr int LDS_BYTES = 147456;
static_assert(MISC_OFF + 128 <= LDS_BYTES, "LDS map");

#define GAS __attribute__((address_space(1)))
#define LAS __attribute__((address_space(3)))
typedef unsigned short bf16;
typedef unsigned v4u __attribute__((ext_vector_type(4)));
typedef unsigned v2u __attribute__((ext_vector_type(2)));
typedef float f32x4 __attribute__((ext_vector_type(4)));
typedef short bf16x8 __attribute__((ext_vector_type(8)));
typedef short v4i16_t __attribute__((ext_vector_type(4)));
typedef GAS unsigned gu32;
#define RLX_AGENT __ATOMIC_RELAXED, __HIP_MEMORY_SCOPE_AGENT
#define LDS_WAIT() asm volatile("s_waitcnt lgkmcnt(0)" ::: "memory")
#define VM_WAIT() asm volatile("s_waitcnt vmcnt(0)" ::: "memory")
__device__ __forceinline__ unsigned f2bf(float f) { unsigned u = __builtin_bit_cast(unsigned, f); return (u + 0x7fffu + ((u >> 16) & 1u)) >> 16; }
__device__ __forceinline__ unsigned pk2(float lo, float hi) { return pg8::cvt_pk_bf16(lo, hi); }
__device__ __forceinline__ float bflo(unsigned w) { return __builtin_bit_cast(float, w << 16); }
__device__ __forceinline__ float bfhi(unsigned w) { return __builtin_bit_cast(float, w & 0xffff0000u); }

#define XB_TMO      128
#define XB_XCNT(j)  (256  + 64 * (j))
#define XB_XSUB(j)  (1280 + 64 * (j))
#define XB_XGEN(j)  (2304 + 64 * (j))
#define XB_TOP      3328
#define XB_TOPGEN   3392
#define XCD_BAR_WORDS 3456
#define XB_SPIN_CAP (1u << 20)

__device__ __forceinline__ unsigned xb_ld(unsigned* p)              { return __hip_atomic_load(p, __ATOMIC_RELAXED, __HIP_MEMORY_SCOPE_AGENT); }
__device__ __forceinline__ unsigned xb_add(unsigned* p, unsigned v) { return __hip_atomic_fetch_add(p, v, __ATOMIC_RELAXED, __HIP_MEMORY_SCOPE_AGENT); }
__device__ __forceinline__ unsigned xb_xcc_id() { return (unsigned)__builtin_amdgcn_s_getreg((3 << 11) | 20) & 0xFu; }
#define XB_SPIN(cond, bar) do { unsigned _sp = 0; while (cond) { __builtin_amdgcn_s_sleep(1); \
    if ((++_sp & 255u) == 0u) { if (xb_ld(&(bar)[XB_TMO])) break; if (_sp > XB_SPIN_CAP) { atomicAdd(&(bar)[XB_TMO], 1u); break; } } } } while (0)

struct XcdBarrier { unsigned* bar; unsigned x; volatile LAS unsigned* st; };

__device__ __forceinline__ XcdBarrier xcd_barrier_post(unsigned* bar, volatile LAS unsigned* st) {
    XcdBarrier b; b.bar = bar; b.x = xb_xcc_id(); b.st = st;
    if (threadIdx.x == 0) (void)xb_add(&bar[XB_XCNT(b.x)], 1u);
    return b;
}
__device__ __forceinline__ void xcd_barrier_complete(unsigned* bar, unsigned x, unsigned& nloc, unsigned& nx) {
    const unsigned G = gridDim.x * gridDim.y * gridDim.z;
    unsigned sum, cnt, mine, sp = 0u;
    for (;;) {
        sum = 0u; cnt = 0u; mine = 0u;
#pragma unroll
        for (unsigned j = 0; j < 16; ++j) { const unsigned c = xb_ld(&bar[XB_XCNT(j)]); sum += c; cnt += (c > 0u) ? 1u : 0u; mine = (j == x) ? c : mine; }
        if (sum == G) break;
        __builtin_amdgcn_s_sleep(1);
        if ((++sp & 255u) == 0u) { if (xb_ld(&bar[XB_TMO])) break; if (sp > XB_SPIN_CAP) { atomicAdd(&bar[XB_TMO], 1u); break; } }
    }
    nloc = mine > 0u ? mine : 1u; nx = cnt > 0u ? cnt : 1u;
}
__device__ __forceinline__ void xcd_barrier(const XcdBarrier& b) {
    asm volatile("s_waitcnt vmcnt(0)" ::: "memory");
    __syncthreads();
    if (threadIdx.x == 0) {
        unsigned* bar = b.bar;
        __builtin_amdgcn_s_waitcnt(0);
        unsigned nloc = b.st[0], nx = b.st[1];
        if (nloc == 0u) { xcd_barrier_complete(bar, b.x, nloc, nx); b.st[0] = nloc; b.st[1] = nx; }
        const unsigned old = xb_add(&bar[XB_XSUB(b.x)], 1u);
        const unsigned gen = old / nloc;
        if (old + 1u == (gen + 1u) * nloc) {
            __builtin_amdgcn_fence(__ATOMIC_RELEASE, "agent");
            asm volatile("s_waitcnt vmcnt(0)" ::: "memory");
            const unsigned og = xb_add(&bar[XB_TOP], 1u);
            const unsigned tg = og / nx;
            if (og + 1u == (tg + 1u) * nx) xb_add(&bar[XB_TOPGEN], 1u);
            else XB_SPIN(xb_ld(&bar[XB_TOPGEN]) == tg, bar);
            __builtin_amdgcn_fence(__ATOMIC_ACQUIRE, "agent");
            xb_add(&bar[XB_XGEN(b.x)], 1u);
            asm volatile("s_waitcnt vmcnt(0)" ::: "memory");
        } else {
            XB_SPIN(xb_ld(&bar[XB_XGEN(b.x)]) == gen, bar);
            __builtin_amdgcn_fence(__ATOMIC_ACQUIRE, "agent");
            asm volatile("s_waitcnt vmcnt(0)" ::: "memory");
        }
    }
    __syncthreads();
}

struct Args { const float* in[17]; float* out; unsigned char* ws; int ph_lo, ph_hi; };
typedef const __attribute__((address_space(4))) Args* ArgsP;
__device__ __forceinline__ ArgsP opaque_args() { ArgsP p = (ArgsP)__builtin_amdgcn_kernarg_segment_ptr(); asm volatile("" : "+s"(p)); return p; }
enum { I_X = 0, I_C, I_WADA, I_BADA, I_TABLE, I_N1W, I_WIN, I_VNW, I_WS, I_BS, I_QNW, I_KNW, I_RPB, I_WOUT, I_N2W, I_W1, I_W2 };
struct Frame {
    LAS unsigned char* lds;
    int vcu, G;
};
#define OPAQUE_TID(t) int t = threadIdx.x; asm volatile("" : "+v"(t))

__device__ __forceinline__ float wave_sum(float v) {
#pragma unroll
    for (int o = 1; o < 64; o <<= 1) v += __shfl_xor(v, o);
    return v;
}

template <bool BIAS>
__device__ __forceinline__ void p0_transpose_item(const float* W, int K, int N, bf16* WT, LAS float* scr, int item, int lane, const float* sA, const float* sB, float* bpart, const float* nw) {
    const int nblk = N / 32, kb = item / nblk, nb = item % nblk, k0 = 64 * kb, n0 = 32 * nb;
    float sv = 0.f; if (BIAS) sv = sA[k0 + lane] + sB[k0 + lane];
#pragma unroll 8
    for (int i = 0; i < 32; ++i) { const int kk = 2 * i + (lane >> 5); scr[kk * 33 + (lane & 31)] = W[(size_t)(k0 + kk) * N + n0 + (lane & 31)]; }
    LDS_WAIT(); asm volatile("" ::: "memory");
    const int c = lane & 7;
    float gk[8];
#pragma unroll
    for (int i = 0; i < 8; ++i) gk[i] = 1.0f;
    if (BIAS) { const int kq = k0 + 8 * c; const f32x4 w0 = *(const GAS f32x4*)(nw + kq), w1 = *(const GAS f32x4*)(nw + kq + 4);
        const f32x4 a0 = *(const GAS f32x4*)(sA + D + kq) + *(const GAS f32x4*)(sB + D + kq), a1 = *(const GAS f32x4*)(sA + D + kq + 4) + *(const GAS f32x4*)(sB + D + kq + 4);
#pragma unroll
        for (int i = 0; i < 4; ++i) { gk[i] = w0[i] * (1.0f + a0[i]); gk[4 + i] = w1[i] * (1.0f + a1[i]); } }
#pragma unroll
    for (int j = 0; j < 4; ++j) { const int n = (lane >> 3) + 8 * j; const LAS float* s = scr + (8 * c) * 33 + n;
        v4u o; o.x = pk2(s[0 * 33] * gk[0], s[1 * 33] * gk[1]); o.y = pk2(s[2 * 33] * gk[2], s[3 * 33] * gk[3]); o.z = pk2(s[4 * 33] * gk[4], s[5 * 33] * gk[5]); o.w = pk2(s[6 * 33] * gk[6], s[7 * 33] * gk[7]);
        *(GAS v4u*)(WT + pg8::ioffB(n0 + n, k0 + 8 * c, N)) = o; }
    if (BIAS) {
        const int n = lane & 31, half = lane >> 5; const int svi = __builtin_bit_cast(int, sv); float bsum = 0.f;
#pragma unroll
        for (int kk = 0; kk < 32; ++kk) { const float se = __builtin_bit_cast(float, __builtin_amdgcn_readlane(svi, 2 * kk)), so = __builtin_bit_cast(float, __builtin_amdgcn_readlane(svi, 2 * kk + 1));
            bsum += (half ? so : se) * scr[(2 * kk + half) * 33 + n]; }
        bsum += __shfl_xor(bsum, 32);
        if (lane < 32) bpart[(size_t)kb * N + n0 + n] = bsum;
    }
    LDS_WAIT(); asm volatile("" ::: "memory");
}

__device__ __forceinline__ void p0a_cond(const Frame& F, ArgsP A) {
    OPAQUE_TID(tid);
    float* cond = (float*)(A->ws + WS_COND);
    for (int slab = F.vcu; slab < 256; slab += F.G) {
        const int q = tid % 24, kg = tid / 24, col0 = slab * 96 + 4 * q;
        const float* cvec = A->in[I_C]; const float* wada = A->in[I_WADA];
        f32x4 a = (f32x4){0.f, 0.f, 0.f, 0.f};
        if (tid < 504) {
#pragma unroll 4
            for (int k = kg; k < D; k += 21) { const float cv = cvec[k]; const float s = cv * __builtin_amdgcn_rcpf(1.0f + __expf(-cv));
                a += *(const GAS f32x4*)(wada + (size_t)k * (NMOD * D) + col0) * s; }
            *(LAS f32x4*)(F.lds + (size_t)(kg * 24 + q) * 16) = a;
        }
        __syncthreads();
        if (tid < 96) { float s = 0.f;
            for (int g = 0; g < 21; ++g) s += ((const LAS float*)F.lds)[(g * 24 + (tid >> 2)) * 4 + (tid & 3)];
            cond[slab * 96 + tid] = s + A->in[I_BADA][slab * 96 + tid]; }
        __syncthreads();
    }
    { const int gt = F.vcu * 512 + tid, NT = F.G * 512; const float* w_s = A->in[I_WS]; bf16* WSB = (bf16*)(A->ws + WS_WSB);
      for (int i = gt; i < DEPTH * NHEAD * CHUNK * CHUNK / 4; i += NT) { const f32x4 v = ((const GAS f32x4*)w_s)[i]; v2u o; o.x = pk2(v[0], v[1]); o.y = pk2(v[2], v[3]); ((GAS v2u*)WSB)[i] = o; } }
}

__device__ __forceinline__ void p0b_weights(const Frame& F, ArgsP A) {
    OPAQUE_TID(tid); const int lane = tid & 63, wave = __builtin_amdgcn_readfirstlane(tid >> 6);
    const float* cond = (const float*)(A->ws + WS_COND); const float* table = A->in[I_TABLE];
    { float* gate = (float*)(A->ws + WS_GATE);
      for (int i = F.vcu * 512 + tid; i < DEPTH * 2 * D; i += F.G * 512) { const int l = i / (2 * D), w = (i / D) & 1, cidx = i % D;
        gate[i] = cond[(3 * w + 2) * D + cidx] + table[((size_t)l * NMOD + 3 * w + 2) * D + cidx]; } }
    LAS float* scr = (LAS float*)(F.lds + RING_OFF + wave * 16384);
    const int gw = F.vcu * NWAVES + wave, NGW = F.G * NWAVES;
    constexpr int I_IN = (D / 64) * (DIN / 32), I_OUT = (D / 64) * (D / 32), I_1 = (D / 64) * (DFF / 32), I_2 = (DFF / 64) * (D / 32);
    constexpr int I_LAYER = I_IN + I_OUT + I_1 + I_2;
    for (int it = gw; it < DEPTH * I_LAYER; it += NGW) {
        const int l = it / I_LAYER; int r = it - l * I_LAYER;
        if (r < I_IN) { p0_transpose_item<true>(A->in[I_WIN] + (size_t)l * D * DIN, D, DIN, (bf16*)(A->ws + WS_WIN) + (size_t)l * DIN * D, scr, r, lane,
                                                cond, table + (size_t)l * NMOD * D, (float*)(A->ws + WS_BP1) + (size_t)l * 64 * DIN, A->in[I_N1W] + (size_t)l * D); continue; } r -= I_IN;
        if (r < I_OUT) { p0_transpose_item<false>(A->in[I_WOUT] + (size_t)l * D * D, D, D, (bf16*)(A->ws + WS_WOUT) + (size_t)l * D * D, scr, r, lane, nullptr, nullptr, nullptr, nullptr); continue; } r -= I_OUT;
        if (r < I_1) { p0_transpose_item<true>(A->in[I_W1] + (size_t)l * D * DFF, D, DFF, (bf16*)(A->ws + WS_W1) + (size_t)l * DFF * D, scr, r, lane,
                                               cond + 3 * D, table + ((size_t)l * NMOD + 3) * D, (float*)(A->ws + WS_BP3) + (size_t)l * 64 * DFF, A->in[I_N2W] + (size_t)l * D); continue; } r -= I_1;
        p0_transpose_item<false>(A->in[I_W2] + (size_t)l * DFF * D, DFF, D, (bf16*)(A->ws + WS_W2) + (size_t)l * D * DFF, scr, r, lane, nullptr, nullptr, nullptr, nullptr);
    }
}

__device__ __forceinline__ void p1_prep(const Frame& F, ArgsP A) {
    OPAQUE_TID(tid); const int lane = tid & 63, wave = __builtin_amdgcn_readfirstlane(tid >> 6);
    { const float* bp1 = (const float*)(A->ws + WS_BP1); const float* bp3 = (const float*)(A->ws + WS_BP3);
      float* b1 = (float*)(A->ws + WS_BIAS1); float* b3 = (float*)(A->ws + WS_BIAS3);
      for (int i = F.vcu * 512 + tid; i < DEPTH * (DIN + DFF); i += F.G * 512) {
        if (i < DEPTH * DIN) { const int l = i / DIN, n = i % DIN; const float* p = bp1 + (size_t)l * 64 * DIN + n; float s = 0.f;
            for (int kb = 0; kb < 64; ++kb) s += p[(size_t)kb * DIN]; b1[i] = s; }
        else { const int j = i - DEPTH * DIN, l = j / DFF, n = j % DFF; const float* p = bp3 + (size_t)l * 64 * DFF + n; float s = 0.f;
            for (int kb = 0; kb < 64; ++kb) s += p[(size_t)kb * DFF]; b3[j] = s; } } }
    const float* x = A->in[I_X]; bf16* H = (bf16*)(A->ws + WS_H); float* ssq = (float*)(A->ws + WS_SSQ);
    const int gw = F.vcu * NWAVES + wave, NGW = F.G * NWAVES;
    for (int m = gw; m < M; m += NGW) {
        const GAS f32x4* xr = (const GAS f32x4*)(x + (size_t)m * D) + lane;
        f32x4 v[16]; float s = 0.f;
#pragma unroll
        for (int j = 0; j < 16; ++j) { v[j] = xr[64 * j]; }
#pragma unroll
        for (int j = 0; j < 16; ++j) { s += (v[j][0] * v[j][0] + v[j][1] * v[j][1]) + (v[j][2] * v[j][2] + v[j][3] * v[j][3]); }
        s = wave_sum(s);
        const size_t hb0 = pg8::ioff(m, 4 * lane, M);
#pragma unroll
        for (int j = 0; j < 16; ++j) { const f32x4 h = v[j];
            v2u o; o.x = pk2(h[0], h[1]); o.y = pk2(h[2], h[3]); *(GAS v2u*)(H + hb0 + (size_t)j * 4 * pg8::IMG_KT) = o; }
        if (lane < 16) ssq[(size_t)m * 16 + lane] = (lane == 0) ? s : 0.f;
    }
    __syncthreads();
}

#define ZPLANE(Z_, pl) ((Z_) + (size_t)(pl) * M * HD)
constexpr int TROW = 272;
__device__ __forceinline__ bf16x8 tr_pair(const LAS unsigned char* p0, const LAS unsigned char* p1) {
    const v4i16_t lo = __builtin_amdgcn_ds_read_tr16_b64_v4i16((LAS v4i16_t*)p0);
    const v4i16_t hi = __builtin_amdgcn_ds_read_tr16_b64_v4i16((LAS v4i16_t*)p1);
    return __builtin_shufflevector(lo, hi, 0, 1, 2, 3, 4, 5, 6, 7);
}

__device__ __forceinline__ void gmlp_phase(const Frame& F, ArgsP A, int tid, int l) {
    LAS unsigned char* lds = F.lds + RING_OFF;
    const int lane = tid & 63, w = __builtin_amdgcn_readfirstlane(tid >> 6), li = lane & 15, g = lane >> 4, q = li >> 2, p = li & 3;
    const int dh = w & 3, ph = w >> 2;
    const bf16* Z = (const bf16*)(A->ws + WS_Z); bf16* CAT = (bf16*)(A->ws + WS_CAT); const bf16* WSB = (const bf16*)(A->ws + WS_WSB) + (size_t)l * NHEAD * CHUNK * CHUNK;
    const float* b_s = A->in[I_BS] + l * NHEAD * CHUNK;
    constexpr int NU = NHEAD * (M / CHUNK);
    const int upw = (NU + F.G - 1) / F.G;
    int u = F.vcu * upw; asm volatile("" : "+s"(u)); const int uend = min(u + upw, NU);
    const int ptok = tid >> 4, pch = tid & 15;
    const int prow = 64 * ph + li, dcol = 32 * dh + 4 * g;
    while (u < uend) {
        const int h = u >> 7, segend = min(uend, (h + 1) * 128);
        bf16x8 wsf[4][4]; float bs[4];
        { const bf16* wsp = WSB + ((size_t)h * CHUNK + prow) * CHUNK + 8 * g;
#pragma unroll
          for (int pbi = 0; pbi < 4; ++pbi) {
#pragma unroll
              for (int ks = 0; ks < 4; ++ks) wsf[pbi][ks] = *(const GAS bf16x8*)(wsp + (size_t)(16 * pbi) * CHUNK + 32 * ks);
              bs[pbi] = b_s[h * CHUNK + prow + 16 * pbi]; } }
        v4u vt[4];
        { const bf16* vsrc = ZPLANE(Z, 16 + h) + (size_t)((u & 127) * CHUNK + ptok) * HD + pch * 8;
#pragma unroll
          for (int j = 0; j < 4; ++j) vt[j] = *(const GAS v4u*)(vsrc + (size_t)(32 * j) * HD); }
        for (; u < segend; ++u) {
            const int n = u & 127;
#pragma unroll
            for (int j = 0; j < 4; ++j) *(LAS v4u*)(lds + (ptok + 32 * j) * TROW + pch * 16) = vt[j];
            __syncthreads();
            { const int nn = (u + 1 < segend) ? ((u + 1) & 127) : n;
              const bf16* vsrc = ZPLANE(Z, 16 + h) + (size_t)(nn * CHUNK + ptok) * HD + pch * 8;
#pragma unroll
              for (int j = 0; j < 4; ++j) vt[j] = *(const GAS v4u*)(vsrc + (size_t)(32 * j) * HD); }
            v2u uu[2][4];
            { const bf16* up = ZPLANE(Z, h) + ((size_t)n * CHUNK + prow) * HD + dcol;
#pragma unroll
              for (int dbi = 0; dbi < 2; ++dbi)
#pragma unroll
                  for (int pbi = 0; pbi < 4; ++pbi) uu[dbi][pbi] = *(const GAS v2u*)(up + (size_t)(16 * pbi) * HD + 16 * dbi); }
            f32x4 acc[2][4];
#pragma unroll
            for (int dbi = 0; dbi < 2; ++dbi)
#pragma unroll
                for (int pbi = 0; pbi < 4; ++pbi) acc[dbi][pbi] = (f32x4){0.f, 0.f, 0.f, 0.f};
#pragma unroll
            for (int ks = 0; ks < 4; ++ks) {
                const LAS unsigned char* base = lds + (32 * ks + 8 * g + q) * TROW + 64 * dh + 8 * p;
                const bf16x8 a0 = tr_pair(base, base + 4 * TROW), a1 = tr_pair(base + 32, base + 4 * TROW + 32);
#pragma unroll
                for (int pbi = 0; pbi < 4; ++pbi) { acc[0][pbi] = __builtin_amdgcn_mfma_f32_16x16x32_bf16(a0, wsf[pbi][ks], acc[0][pbi], 0, 0, 0);
                                                    acc[1][pbi] = __builtin_amdgcn_mfma_f32_16x16x32_bf16(a1, wsf[pbi][ks], acc[1][pbi], 0, 0, 0); }
            }
            { const size_t ob0 = pg8::ioff(n * CHUNK + prow, h * HD + dcol, M), ob1 = pg8::ioff(n * CHUNK + prow, h * HD + dcol + 16, M);
#pragma unroll
              for (int dbi = 0; dbi < 2; ++dbi)
#pragma unroll
                  for (int pbi = 0; pbi < 4; ++pbi) { const v2u x = uu[dbi][pbi]; const float b = bs[pbi]; const f32x4 a = acc[dbi][pbi];
                    const float o0 = bflo(x.x) * (a[0] + b), o1 = bfhi(x.x) * (a[1] + b), o2 = bflo(x.y) * (a[2] + b), o3 = bfhi(x.y) * (a[3] + b);
                    v2u o; o.x = pg8::cvt_pk_bf16(o0, o1); o.y = pg8::cvt_pk_bf16(o2, o3); *(GAS v2u*)(CAT + (dbi ? ob1 : ob0) + pbi * 1024) = o; } }
            __syncthreads();
        }
    }
}

constexpr int NA_VOFF = 64 * TROW, NA_BUF = 2 * 64 * TROW, NA_BIAS_OFF = 2 * NA_BUF, NA_STEPS = 12;
static_assert(NA_BIAS_OFF + 2 * 512 * 4 <= RING_BYTES, "NA LDS");
__device__ __forceinline__ void na_load_tile(v4u (&st)[4], const char* ub, unsigned voff) {
    st[0] = *(const GAS v4u*)(ub + voff); st[1] = *(const GAS v4u*)(ub + (size_t)32 * HD * 2 + voff);
    st[2] = *(const GAS v4u*)(ub + (size_t)16 * M * HD * 2 + voff); st[3] = *(const GAS v4u*)(ub + (size_t)16 * M * HD * 2 + (size_t)32 * HD * 2 + voff);
}
__device__ __forceinline__ void na_write_tile(LAS unsigned char* dst, const v4u (&st)[4]) {
    *(LAS v4u*)(dst) = st[0]; *(LAS v4u*)(dst + 32 * TROW) = st[1]; *(LAS v4u*)(dst + NA_VOFF) = st[2]; *(LAS v4u*)(dst + NA_VOFF + 32 * TROW) = st[3];
}
__device__ __forceinline__ void na_block(const LAS unsigned char* kbuf, const LAS unsigned char* vbuf, const bf16x8 (&qf)[4], f32x4 (&O)[8], float& m, float& lsum,
                                         const LAS float* brow, int vbits, int boff, int key0, int li, int g, int q, int p) {
    f32x4 S[2];
#pragma unroll
    for (int kb = 0; kb < 2; ++kb) { f32x4 a = (f32x4){0.f, 0.f, 0.f, 0.f};
#pragma unroll
        for (int ks = 0; ks < 4; ++ks) { const bf16x8 kf = *(const LAS bf16x8*)(kbuf + (key0 + 16 * kb + li) * TROW + 64 * ks + 16 * g); a = __builtin_amdgcn_mfma_f32_16x16x32_bf16(kf, qf[ks], a, 0, 0, 0); }
        S[kb] = a; }
    const LAS float* bp = brow + boff;
    float mx = -INFINITY;
#pragma unroll
    for (int kb = 0; kb < 2; ++kb)
#pragma unroll
        for (int e = 0; e < 4; ++e) { const int t = __builtin_amdgcn_sbfe(vbits, 4 * kb + e, 1);
            const float s = __builtin_bit_cast(float, (__builtin_bit_cast(int, S[kb][e] + bp[16 * kb + e]) & t) | (~t & (int)0xff800000)); S[kb][e] = s; mx = fmaxf(mx, s); }
    mx = fmaxf(mx, __shfl_xor(mx, 16)); mx = fmaxf(mx, __shfl_xor(mx, 32));
    if (__any(mx > m + 8.0f)) {
        const float mnew = fmaxf(m, mx), alpha = __builtin_amdgcn_exp2f(m - mnew); m = mnew; lsum *= alpha;
#pragma unroll
        for (int db = 0; db < 8; ++db) O[db] = O[db] * alpha;
    }
    float ps = 0.f;
#pragma unroll
    for (int kb = 0; kb < 2; ++kb)
#pragma unroll
        for (int e = 0; e < 4; ++e) { const float pe = __builtin_amdgcn_exp2f(S[kb][e] - m); S[kb][e] = pe; ps += pe; }
    lsum += ps;
    v4u pw; pw.x = pg8::cvt_pk_bf16(S[0][0], S[0][1]); pw.y = pg8::cvt_pk_bf16(S[0][2], S[0][3]); pw.z = pg8::cvt_pk_bf16(S[1][0], S[1][1]); pw.w = pg8::cvt_pk_bf16(S[1][2], S[1][3]);
    const bf16x8 pf = __builtin_bit_cast(bf16x8, pw);
    const LAS unsigned char* vb_ = vbuf + (key0 + 4 * g + q) * TROW + 8 * p;
#pragma unroll
    for (int db = 0; db < 8; ++db) { const bf16x8 a = tr_pair(vb_ + 32 * db, vb_ + 16 * TROW + 32 * db);
        O[db] = __builtin_amdgcn_mfma_f32_16x16x32_bf16(a, pf, O[db], 0, 0, 0); }
}
__device__ __forceinline__ void na_phase(const Frame& F, ArgsP A, int tid, int l) {
    LAS unsigned char* lds = F.lds + RING_OFF;
    const int lane = tid & 63, w = __builtin_amdgcn_readfirstlane(tid >> 6), li = lane & 15, g = lane >> 4, q = li >> 2, p = li & 3;
    const int rw = w >> 1, qh = w & 1;
    const bf16* Z = (const bf16*)(A->ws + WS_Z); bf16* CAT = (bf16*)(A->ws + WS_CAT);
    const float* rpb = A->in[I_RPB] + (size_t)l * NHEAD * RPB_N;
    constexpr int NRG = GRID_ROWS / 4, NU = NHEAD * NRG;
    int u = F.vcu; asm volatile("" : "+s"(u));
    if (u >= NU) return;
    const int c0 = 32 * qh + li, c1 = c0 + 16;
    const int cs0 = min(max(c0 - WIN_C / 2, 0), GRID_W - WIN_C), cs1 = min(max(c1 - WIN_C / 2, 0), GRID_W - WIN_C);
    const int k00 = qh ? 24 : 0, k01 = qh ? 32 : 8;
    int vb0 = 0, vb1 = 0;
#pragma unroll
    for (int i = 0; i < 8; ++i) { const int kc0 = k00 + 16 * (i >> 2) + 4 * g + (i & 3), kc1 = k01 + 16 * (i >> 2) + 4 * g + (i & 3);
        vb0 |= ((kc0 >= cs0) && (kc0 < cs0 + WIN_C)) ? (1 << i) : 0; vb1 |= ((kc1 >= cs1) && (kc1 < cs1 + WIN_C)) ? (1 << i) : 0; }
    const int bo0 = k00 + 4 * g - c0 + (WIN_C - 1), bo1 = k01 + 4 * g - c1 + (WIN_C - 1);
    const int sk = tid >> 4, sc = tid & 15;
    const unsigned st_voff = (unsigned)(sk * HD + sc * 8) * 2u;
    LAS unsigned char* st_lds = lds + sk * TROW + sc * 16;
    LAS float* btab = (LAS float*)(lds + NA_BIAS_OFF);
#define NA_TSRC(ru_, h_, j) ((const char*)(ZPLANE(Z, 48 + (h_)) + (size_t)(min((ru_) + (j), GRID_ROWS - 1) * GRID_W) * HD)), st_voff
#define NA_RS(r_) min(max((r_) - WIN_R / 2, 0), GRID_ROWS - WIN_R)
    int rg = u & (NRG - 1), h = u / NRG, ru = NA_RS(4 * rg), par = 0;
    v4u R[4][4]; bf16x8 qf0[4], qf1[4];
    na_load_tile(R[0], NA_TSRC(ru, h, 0)); na_load_tile(R[1], NA_TSRC(ru, h, 1)); na_load_tile(R[2], NA_TSRC(ru, h, 2)); na_load_tile(R[3], NA_TSRC(ru, h, 3));
    if (tid < RPB_N) btab[tid] = rpb[(size_t)h * RPB_N + tid] * 1.4426950408889634f;
    na_write_tile(st_lds, R[0]); na_load_tile(R[0], NA_TSRC(ru, h, 4));
    __syncthreads();
    for (;;) {
        const int un = u + F.G; const bool has_next = un < NU; const int uq = has_next ? un : u;
        const int rgn = uq & (NRG - 1), hn = uq / NRG, run = NA_RS(4 * rgn);
        const int r = 4 * rg + rw, rs = NA_RS(r);
        { const bf16* qp = ZPLANE(Z, 32 + h) + (size_t)(r * GRID_W + c0) * HD + 8 * g;
#pragma unroll
          for (int ks = 0; ks < 4; ++ks) { qf0[ks] = *(const GAS bf16x8*)(qp + 32 * ks); qf1[ks] = *(const GAS bf16x8*)(qp + (size_t)16 * HD + 32 * ks); } }
        const LAS float* bth = btab + par * 512;
        f32x4 O0[8], O1[8]; float m0 = -INFINITY, m1 = -INFINITY, l0 = 0.f, l1 = 0.f;
#pragma unroll
        for (int db = 0; db < 8; ++db) { O0[db] = (f32x4){0.f, 0.f, 0.f, 0.f}; O1[db] = (f32x4){0.f, 0.f, 0.f, 0.f}; }
#pragma unroll 1
        for (int jj = 0; jj < NA_STEPS; jj += 4) {
#pragma unroll
          for (int js = 0; js < 4; ++js) { const int j = jj + js;
            na_write_tile(st_lds + ((js + 1) & 1) * NA_BUF, R[(js + 1) & 3]);
            { const bool cur = (j + 5 < NA_STEPS); const int tj = cur ? j + 5 : j + 5 - NA_STEPS, tru = cur ? ru : run, th = cur ? h : hn;
              na_load_tile(R[(js + 1) & 3], NA_TSRC(tru, th, tj)); }
            if (j == 7 && tid < RPB_N) btab[(par ^ 1) * 512 + tid] = rpb[(size_t)hn * RPB_N + tid] * 1.4426950408889634f;
            const int il = ru + j - rs;
            if (il >= 0 && il < WIN_R) {
                const LAS unsigned char* kbuf = lds + (js & 1) * NA_BUF; const LAS unsigned char* vbuf = kbuf + NA_VOFF;
                const LAS float* brow = bth + (ru + j - r + (WIN_R - 1)) * RPB_C;
                na_block(kbuf, vbuf, qf0, O0, m0, l0, brow, vb0, bo0, k00, li, g, q, p);
                na_block(kbuf, vbuf, qf1, O1, m1, l1, brow, vb1, bo1, k01, li, g, q, p);
            }
            __syncthreads();
          }
        }
        l0 += __shfl_xor(l0, 16); l0 += __shfl_xor(l0, 32); l1 += __shfl_xor(l1, 16); l1 += __shfl_xor(l1, 32);
        const float i0 = 1.0f / l0, i1 = 1.0f / l1;
        const int orow = r * GRID_W + c0, ocol = (D / 2) + h * HD + 4 * g;
        const size_t ob0 = pg8::ioff(orow, ocol, M), ob1 = pg8::ioff(orow, ocol + 16, M);
#pragma unroll
        for (int db = 0; db < 8; ++db) {
            v2u o; o.x = pg8::cvt_pk_bf16(O0[db][0] * i0, O0[db][1] * i0); o.y = pg8::cvt_pk_bf16(O0[db][2] * i0, O0[db][3] * i0); *(GAS v2u*)(CAT + ((db & 1) ? ob1 : ob0) + (size_t)(db >> 2) * pg8::IMG_KT + ((db >> 1) & 1) * 512) = o;
            v2u o2; o2.x = pg8::cvt_pk_bf16(O1[db][0] * i1, O1[db][1] * i1); o2.y = pg8::cvt_pk_bf16(O1[db][2] * i1, O1[db][3] * i1); *(GAS v2u*)(CAT + ((db & 1) ? ob1 : ob0) + (size_t)(db >> 2) * pg8::IMG_KT + ((db >> 1) & 1) * 512 + 1024) = o2; }
        if (!has_next) break;
        u = un; rg = rgn; h = hn; ru = run; par ^= 1;
    }
#undef NA_TSRC
#undef NA_RS
    __syncthreads();
}

__device__ __forceinline__ void mixer_phase(const Frame& F, ArgsP A, int l) {
    OPAQUE_TID(tid);
    gmlp_phase(F, A, tid, l);
    na_phase(F, A, tid, l);
}

constexpr int N_PHASES = 3 + 5 * DEPTH;

__global__ void __launch_bounds__(NWAVES * 64, 2) enc_fwd(Args args) {
    extern __shared__ __attribute__((aligned(16))) unsigned char lds[];
    Frame F;
    F.lds = (LAS unsigned char*)lds;
    F.G = gridDim.x; { const int bx = blockIdx.x; F.vcu = (F.G % 8 == 0) ? (bx % 8) * (F.G / 8) + bx / 8 : bx; }
    { OPAQUE_TID(t0); for (int u = t0; u < (LDS_BYTES - LDSCTL_OFF) / 4; u += NWAVES * 64) ((LAS unsigned*)(F.lds + LDSCTL_OFF))[u] = 0u; }
    __syncthreads();
    unsigned* barw = (unsigned*)(args.ws + WS_CTL) + CW_BAR;
    XcdBarrier bar; bar.bar = barw; bar.x = 0; bar.st = nullptr;
    if (!MK_PER_PHASE) bar = xcd_barrier_post(barw, (volatile LAS unsigned*)(F.lds + MISC_OFF) + 8);

    const int lo = args.ph_lo, hi = args.ph_hi;
#define IN(k) (lo <= (k) && (k) < hi)
#define SEAM(k) do { if (IN(k) && IN((k) + 1)) xcd_barrier(bar); } while (0)

    if (IN(0)) { ArgsP A = opaque_args(); p0a_cond(F, A); } SEAM(0);
    if (IN(1)) { ArgsP A = opaque_args(); p0b_weights(F, A); } SEAM(1);
    if (IN(2)) { ArgsP A = opaque_args(); p1_prep(F, A); } SEAM(2);

#pragma unroll 1
    for (int l = 0; l < DEPTH; ++l) {
        const int pb = 3 + 5 * l;
        if (IN(pb + 0)) { ArgsP args = opaque_args();
            pg8::Gemm g{(const bf16*)(args->ws + WS_H), (const bf16*)(args->ws + WS_WIN) + (size_t)l * DIN * D, M, DIN, D}; pg8::StaticOrder S; S.init(M, DIN, F.G, (int)blockIdx.x);
            pg8::EpiIn E{(bf16*)(args->ws + WS_Z), args->in[I_VNW] + (size_t)l * NHEAD * HD, args->in[I_QNW] + (size_t)l * HD, args->in[I_KNW] + (size_t)l * HD,
                         pg8::RowScale{(const float*)(args->ws + WS_SSQ), (const float*)(args->ws + WS_BIAS1) + (size_t)l * DIN, (PG8_LAS float*)(F.lds + RTAB_OFF), (PG8_LAS float*)(F.lds + BTAB_OFF)}, (PG8_LAS float*)(F.lds + TAB_OFF)};
            pg8::gemm_phase<pg8::EpiIn, pg8::StaticOrder, true, true>(F.lds + RING_OFF, g, S, E);
        }
        SEAM(pb + 0);
        if (IN(pb + 1)) { ArgsP args = opaque_args(); mixer_phase(F, args, l); }
        SEAM(pb + 1);
        if (IN(pb + 2)) { ArgsP args = opaque_args();
            pg8::Gemm g{(const bf16*)(args->ws + WS_CAT), (const bf16*)(args->ws + WS_WOUT) + (size_t)l * D * D, M, D, D}; pg8::StaticOrder S; S.init(M, D, F.G, (int)blockIdx.x);
            pg8::EpiResid E{(const float*)nullptr, (bf16*)(args->ws + WS_H), (float*)nullptr, (const float*)(args->ws + WS_GATE) + (size_t)(2 * l) * D,
                            (float*)(args->ws + WS_SSQ), (PG8_LAS float*)(F.lds + TAB_OFF), D};
            pg8::gemm_phase<pg8::EpiResid, pg8::StaticOrder, true, true>(F.lds + RING_OFF, g, S, E);
        }
        SEAM(pb + 2);
        if (IN(pb + 3)) { ArgsP args = opaque_args();
            pg8::Gemm g{(const bf16*)(args->ws + WS_H), (const bf16*)(args->ws + WS_W1) + (size_t)l * DFF * D, M, DFF, D}; pg8::StaticOrder S; S.init(M, DFF, F.G, (int)blockIdx.x);
            pg8::EpiRelu2 E{(bf16*)(args->ws + WS_HID), DFF, pg8::RowScale{(const float*)(args->ws + WS_SSQ), (const float*)(args->ws + WS_BIAS3) + (size_t)l * DFF, (PG8_LAS float*)(F.lds + RTAB_OFF), (PG8_LAS float*)(F.lds + BTAB_OFF)}};
            pg8::gemm_phase<pg8::EpiRelu2, pg8::StaticOrder, true, true>(F.lds + RING_OFF, g, S, E);
        }
        SEAM(pb + 3);
        if (IN(pb + 4)) { ArgsP args = opaque_args();
            pg8::Gemm g{(const bf16*)(args->ws + WS_HID), (const bf16*)(args->ws + WS_W2) + (size_t)l * D * DFF, M, D, DFF, 1}; pg8::StaticOrder S; S.init(M, D, F.G, (int)blockIdx.x);
            pg8::EpiResid E{(const float*)nullptr, (bf16*)(args->ws + WS_H), (l + 1 < DEPTH) ? (float*)nullptr : args->out, (const float*)(args->ws + WS_GATE) + (size_t)(2 * l + 1) * D,
                            (float*)(args->ws + WS_SSQ), (PG8_LAS float*)(F.lds + TAB_OFF), D};
            pg8::gemm_phase<pg8::EpiResid, pg8::StaticOrder, true, true>(F.lds + RING_OFF, g, S, E);
        }
        if (l + 1 < DEPTH) SEAM(pb + 4);
    }
#undef IN
#undef SEAM
}

extern "C" void kernel_launch(void* const* d_in, const int* in_sizes, int n_in, void* d_out, int out_size, void* d_ws, size_t ws_size, hipStream_t stream) {
    static int grid = 0;
    if (grid == 0) {
        if (n_in != 17 || in_sizes[0] != M * D || out_size != M * D || ws_size < WS_END) { fprintf(stderr, "kernel_launch: unexpected problem (n_in %d, in0 %d, out %d, ws %zu < %zu); nothing launched\n", n_in, n_in > 0 ? in_sizes[0] : -1, out_size, ws_size, (size_t)WS_END); grid = -1; return; }
        int dev = 0, cus = 0, per_cu = 0;
        if (hipGetDevice(&dev) != hipSuccess || hipDeviceGetAttribute(&cus, hipDeviceAttributeMultiprocessorCount, dev) != hipSuccess) { grid = -1; return; }
        if (hipFuncSetAttribute((const void*)enc_fwd, hipFuncAttributeMaxDynamicSharedMemorySize, LDS_BYTES) != hipSuccess) { fprintf(stderr, "kernel_launch: hipFuncSetAttribute failed\n"); grid = -1; return; }
        if (hipOccupancyMaxActiveBlocksPerMultiprocessor(&per_cu, (const void*)enc_fwd, NWAVES * 64, LDS_BYTES) != hipSuccess || per_cu < 1)
            fprintf(stderr, "kernel_launch: note: occupancy query reports %d workgroups per CU\n", per_cu);
        (void)hipGetLastError();
        grid = cus;
    }
    if (grid < 0) return;
    if (hipMemsetAsync((char*)d_ws + WS_CTL, 0, CTL_ZERO_BYTES, stream) != hipSuccess) { fprintf(stderr, "kernel_launch: hipMemsetAsync failed\n"); return; }
    Args a{};
    for (int i = 0; i < 17; ++i) a.in[i] = (const float*)d_in[i];
    a.out = (float*)d_out; a.ws = (unsigned char*)d_ws;
#if MK_PER_PHASE
    for (int ph = 0; ph < N_PHASES; ++ph) { a.ph_lo = ph; a.ph_hi = ph + 1; hipLaunchKernelGGL(enc_fwd, dim3(grid), dim3(NWAVES * 64), LDS_BYTES, stream, a); }
#else
    a.ph_lo = 0; a.ph_hi = N_PHASES;
    hipLaunchKernelGGL(enc_fwd, dim3(grid), dim3(NWAVES * 64), LDS_BYTES, stream, a);
#endif
    const hipError_t le = hipPeekAtLastError();
    if (le != hipSuccess) fprintf(stderr, "kernel_launch: launch failed: %s\n", hipGetErrorName(le));
}
```
